# Optimizing an MI355X kernel written in HIP

```python
import jax, jax.numpy as jnp
from jax import lax
import numpy as np

D_MODEL = 1024
BATCH = 8
SEQ = 2048
DEPTH = 1
DEC_BATCH = 128
DEC_SEQ = 8
PAST_LEN = 16384
PAGE_SIZE = 128

D_MIX = D_MODEL
D_CONV = D_MIX // 2
D_POOL = D_MIX - D_CONV
CONV_HEADS = 8
CONV_WIDTH = 31
POOL_WINDOWS = (2, 4, 8, 16)
POOL_GROUPS = len(POOL_WINDOWS)
POOL_GROUP_DIM = D_POOL // POOL_GROUPS
POOL_MAX = max(POOL_WINDOWS)
D_FF = 2816
N_MOD = 9
HALF = 0.5
EPS = 1e-6

kernel_name = "hybrid_conformer_conv_multiscale_pool_decoder_step"


def _rmsnorm(x, g):
    xf = x.astype(jnp.float32)
    y = xf * lax.rsqrt(jnp.mean(xf * xf, axis=-1, keepdims=True) + EPS)
    return (y * g.astype(jnp.float32)).astype(x.dtype)


def _layernorm(x, g, b):
    xf = x.astype(jnp.float32)
    mu = jnp.mean(xf, axis=-1, keepdims=True)
    var = jnp.mean(jnp.square(xf - mu), axis=-1, keepdims=True)
    y = (xf - mu) * lax.rsqrt(var + EPS)
    return (y * g.astype(jnp.float32) + b.astype(jnp.float32)).astype(x.dtype)


def _swiglu(x, w_up, w_down):
    gu = x @ w_up
    g, u = jnp.split(gu, 2, axis=-1)
    return (jax.nn.silu(g) * u) @ w_down


def _depthwise_causal_conv(u_ext, w_dw, b_dw):
    c = u_ext.shape[-1]
    out = lax.conv_general_dilated(
        u_ext, w_dw[:, None, :], window_strides=(1,), padding='VALID',
        dimension_numbers=('NWC', 'WIO', 'NWC'), feature_group_count=c)
    return out + b_dw


def _pool_mix(u_ext, pos0, w_pool, pool_scale):
    bsz, text, _ = u_ext.shape
    t = text - (POOL_MAX - 1)
    uf = u_ext.astype(jnp.float32)
    s0 = jnp.concatenate([jnp.zeros((bsz, 1, D_POOL), jnp.float32), jnp.cumsum(uf, axis=1)], axis=1)
    pos = pos0 + jnp.arange(t, dtype=jnp.int32)
    u_cur = uf[:, POOL_MAX - 1:]
    outs = []
    for gi, w in enumerate(POOL_WINDOWS):
        sl = slice(gi * POOL_GROUP_DIM, (gi + 1) * POOL_GROUP_DIM)
        win_sum = s0[:, POOL_MAX:POOL_MAX + t, sl] - s0[:, POOL_MAX - w:POOL_MAX - w + t, sl]
        count = jnp.minimum(pos + 1, w).astype(jnp.float32)[None, :, None]
        outs.append(win_sum / count - u_cur[:, :, sl])
    pooled = jnp.stack(outs, axis=2).astype(u_ext.dtype)
    mixed = jnp.einsum('btgc,gcd->btgd', pooled, w_pool)
    return mixed.reshape(bsz, t, D_POOL) * pool_scale


def _layer(x, c, conv_prev, pool_prev, pos0,
           w_ada, b_ada, g_ffn1, w_ffn1_up, w_ffn1_down, g_mix, w_in, w_dw, b_dw,
           ln_g, ln_b, w_pool, pool_scale, w_out, g_ffn2, w_ffn2_up, w_ffn2_down):
    bsz = x.shape[0]
    mod = (jax.nn.silu(c) @ w_ada + b_ada).reshape(bsz, N_MOD, 1, D_MODEL)
    sh1, sc1, gt1 = mod[:, 0], mod[:, 1], mod[:, 2]
    shm, scm, gtm = mod[:, 3], mod[:, 4], mod[:, 5]
    sh2, sc2, gt2 = mod[:, 6], mod[:, 7], mod[:, 8]

    x = x + HALF * gt1 * _swiglu(_rmsnorm(x, g_ffn1) * (1 + sc1) + sh1, w_ffn1_up, w_ffn1_down)

    hm = _rmsnorm(x, g_mix) * (1 + scm) + shm
    proj = hm @ w_in
    a = proj[..., :D_CONV]
    g = proj[..., D_CONV:2 * D_CONV]
    u_pool = proj[..., 2 * D_CONV:]
    u_conv = a * jax.nn.sigmoid(g)
    conv_ext = jnp.concatenate([conv_prev, u_conv], axis=1)
    v = _depthwise_causal_conv(conv_ext, w_dw, b_dw)
    v = jax.nn.silu(_layernorm(v, ln_g, ln_b))
    pool_ext = jnp.concatenate([pool_prev, u_pool], axis=1)
    p = _pool_mix(pool_ext, pos0, w_pool, pool_scale)
    mix = jnp.concatenate([v, p], axis=-1) @ w_out
    x = x + gtm * mix

    x = x + HALF * gt2 * _swiglu(_rmsnorm(x, g_ffn2) * (1 + sc2) + sh2, w_ffn2_up, w_ffn2_down)
    return x, conv_ext[:, -(CONV_WIDTH - 1):], pool_ext[:, -(POOL_MAX - 1):]


def setup_inputs(seed: int = 0) -> dict:
    key = jax.random.key(seed)
    ks = jax.random.split(key, 26)

    def nrm(k, shape, scale=1.0):
        return jax.random.normal(k, shape, jnp.float32) * scale

    def gain(k, shape):
        return 1.0 + nrm(k, shape, 0.05)

    return {
        "x_prompt": nrm(ks[0], (BATCH, SEQ, D_MODEL)),
        "x_sample": nrm(ks[1], (DEC_BATCH, DEC_SEQ, D_MODEL)),
        "state_conv": nrm(ks[2], (DEPTH, DEC_BATCH, CONV_WIDTH - 1, D_CONV), 0.5),
        "state_pool": nrm(ks[3], (DEPTH, DEC_BATCH, POOL_MAX - 1, D_POOL)),
        "c_prompt": nrm(ks[4], (BATCH, D_MODEL)),
        "c_sample": nrm(ks[5], (DEC_BATCH, D_MODEL)),
        "w_ada": nrm(ks[6], (DEPTH, D_MODEL, N_MOD * D_MODEL), 0.02),
        "b_ada": nrm(ks[7], (DEPTH, N_MOD * D_MODEL), 0.01),
        "g_ffn1": gain(ks[8], (DEPTH, D_MODEL)),
        "w_ffn1_up": nrm(ks[9], (DEPTH, D_MODEL, 2 * D_FF), D_MODEL ** -0.5),
        "w_ffn1_down": nrm(ks[10], (DEPTH, D_FF, D_MODEL), D_FF ** -0.5),
        "g_mix": gain(ks[11], (DEPTH, D_MODEL)),
        "w_in": nrm(ks[12], (DEPTH, D_MODEL, 2 * D_CONV + D_POOL), D_MODEL ** -0.5),
        "w_dw": nrm(ks[13], (DEPTH, CONV_WIDTH, D_CONV), CONV_WIDTH ** -0.5),
        "b_dw": nrm(ks[14], (DEPTH, D_CONV), 0.01),
        "ln_g": gain(ks[15], (DEPTH, D_CONV)),
        "ln_b": nrm(ks[16], (DEPTH, D_CONV), 0.01),
        "w_pool": nrm(ks[17], (DEPTH, POOL_GROUPS, POOL_GROUP_DIM, POOL_GROUP_DIM), POOL_GROUP_DIM ** -0.5),
        "pool_scale": gain(ks[18], (DEPTH, D_POOL)),
        "w_out": nrm(ks[19], (DEPTH, D_MIX, D_MODEL), D_MIX ** -0.5),
        "g_ffn2": gain(ks[20], (DEPTH, D_MODEL)),
        "w_ffn2_up": nrm(ks[21], (DEPTH, D_MODEL, 2 * D_FF), D_MODEL ** -0.5),
        "w_ffn2_down": nrm(ks[22], (DEPTH, D_FF, D_MODEL), D_FF ** -0.5),
        "g_final": gain(ks[23], (D_MODEL,)),
    }


def reference(x_prompt, x_sample, state_conv, state_pool, c_prompt, c_sample,
              w_ada, b_ada, g_ffn1, w_ffn1_up, w_ffn1_down, g_mix, w_in, w_dw, b_dw,
              ln_g, ln_b, w_pool, pool_scale, w_out, g_ffn2, w_ffn2_up, w_ffn2_down, g_final):
    h_p, h_s = x_prompt, x_sample
    conv_p, pool_p, conv_s, pool_s = [], [], [], []
    for l in range(DEPTH):
        params = (w_ada[l], b_ada[l], g_ffn1[l], w_ffn1_up[l], w_ffn1_down[l], g_mix[l], w_in[l],
                  w_dw[l], b_dw[l], ln_g[l], ln_b[l], w_pool[l], pool_scale[l], w_out[l],
                  g_ffn2[l], w_ffn2_up[l], w_ffn2_down[l])
        bp = h_p.shape[0]
        zero_conv = jnp.zeros((bp, CONV_WIDTH - 1, D_CONV), h_p.dtype)
        zero_pool = jnp.zeros((bp, POOL_MAX - 1, D_POOL), h_p.dtype)
        h_p, cp, pp = _layer(h_p, c_prompt, zero_conv, zero_pool, 0, *params)
        h_s, cs, ps = _layer(h_s, c_sample, state_conv[l], state_pool[l], PAST_LEN, *params)
        conv_p.append(cp)
        pool_p.append(pp)
        conv_s.append(cs)
        pool_s.append(ps)
    y_prompt = _rmsnorm(h_p, g_final)
    y_sample = _rmsnorm(h_s, g_final)
    return (y_prompt, y_sample, jnp.stack(conv_p), jnp.stack(pool_p), jnp.stack(conv_s), jnp.stack(pool_s))
```

```cpp
#include <hip/hip_runtime.h>
#include <hip/hip_cooperative_groups.h>
#include <cstdio>
#include <cstdint>
namespace cg = cooperative_groups;
#define MK_MULTI_LAUNCH 0
namespace pg8 {
#define PG8_LAS __attribute__((address_space(3)))
typedef unsigned short bf16_t;
typedef short bf16x8 __attribute__((ext_vector_type(8)));
typedef float f32x4 __attribute__((ext_vector_type(4)));
typedef unsigned u32x4 __attribute__((ext_vector_type(4)));
constexpr int BM = 256, BK = 64, HALF = 128, HTB = HALF * BK * 2  , STAGE_BYTES = 8 * HTB, NXCD = 8, WGM = 8;

__host__ __device__ __forceinline__ int lds_byte(int r, int c) { const int st = (r >> 4) * 2 + (c >> 5), rr = r & 15, cc = c & 31, ob = rr * 64 + cc * 2; return st * 1024 + (ob ^ (((ob >> 9) & 1) << 5)); }
__host__ __device__ __forceinline__ void stage_rc(int b, int& R, int& C) { const int st = b / 1024, sb = b % 1024, swz = sb ^ (((sb >> 9) & 1) << 5); R = (st >> 1) * 16 + swz / 64; C = (st & 1) * 32 + (swz % 64) / 2; }
__host__ __device__ __forceinline__ int perm32(int rho) { const int n = rho >> 4, i = rho & 15; return 8 * (i >> 2) + 4 * n + (i & 3); }

struct Unit { int pm, pn; };
struct Gemm { const bf16_t* A; const bf16_t* Bt; int M, N, K; };

struct StaticOrder {
    int nM, nN, nwg, G, c;
    __host__ __device__ void init(int M, int N, int G_, int c_) { nM = M / BM; nN = N / BM; nwg = nM * nN; G = G_; c = c_; }
    __host__ __device__ bool next(int i, Unit& u) const {
        const long L = (long)i * G + c; if (L >= nwg) return false;
        int wgid = (int)L; { const int q = nwg / NXCD, r = nwg % NXCD, xcd = wgid % NXCD, off = wgid / NXCD; wgid = (xcd < r ? xcd * (q + 1) : r * (q + 1) + (xcd - r) * q) + off; }
        const int nig = WGM * nN, gid = wgid / nig, fm = gid * WGM, gsz = (nM - fm) < WGM ? (nM - fm) : WGM;
        u.pm = fm + ((wgid % nig) % gsz); u.pn = (wgid % nig) / gsz; return true;
    }
    __device__ __forceinline__ void a_ready(const Unit&) const {}
    __device__ __forceinline__ void done(const Unit&) const {}
};

__device__ __forceinline__ unsigned cvt_pk_bf16(float lo, float hi) { unsigned r; asm volatile("v_cvt_pk_bf16_f32 %0, %1, %2" : "=v"(r) : "v"(lo), "v"(hi)); return r; }
typedef float f32x2 __attribute__((ext_vector_type(2)));
constexpr int NROW_PROMPT = 16384, MODLD = 9216, DM = 1024;
__device__ __forceinline__ int mod_row(int r) { return r < NROW_PROMPT ? (r >> 11) : 8 + ((r - NROW_PROMPT) >> 3); }
__device__ __forceinline__ float sigmoid_f(float g) { return __builtin_amdgcn_rcpf(1.0f + __builtin_amdgcn_exp2f(-1.44269504089f * g)); }

template <int MODE> struct EpiGate {
    static constexpr bool PERM = true, AFTER_DRAIN = false;
    bf16_t* O; int ldc;
    __device__ __forceinline__ void operator()(const f32x4 (&acc)[2][2][4][2], const Unit& u, int wr, int wc, int fr, int fq) const {
        const int row0 = u.pm * BM + wr * 64 + fr;
        if (MODE == 0 || u.pn < 4) {
            const int col0 = u.pn * 128 + wc * 32 + 8 * fq;
#pragma unroll
            for (int ai = 0; ai < 2; ++ai)
#pragma unroll
                for (int m = 0; m < 4; ++m) { bf16_t* rowp = O + (size_t)(row0 + ai * HALF + m * 16) * ldc + col0;
                    float o[8];
#pragma unroll
                    for (int n = 0; n < 2; ++n)
#pragma unroll
                        for (int j = 0; j < 4; ++j) { const float a = acc[ai][0][m][n][j], b = acc[ai][1][m][n][j];
                            o[n * 4 + j] = (MODE == 0) ? a * sigmoid_f(a) * b : a * sigmoid_f(b); }
                    u32x4 w; w.x = cvt_pk_bf16(o[0], o[1]); w.y = cvt_pk_bf16(o[2], o[3]); w.z = cvt_pk_bf16(o[4], o[5]); w.w = cvt_pk_bf16(o[6], o[7]);
                    *(u32x4*)rowp = w; }
        } else {
            const int col0 = 512 + (u.pn - 4) * 256 + wc * 32 + 8 * fq;
#pragma unroll
            for (int ai = 0; ai < 2; ++ai)
#pragma unroll
                for (int m = 0; m < 4; ++m) { bf16_t* rowp = O + (size_t)(row0 + ai * HALF + m * 16) * ldc + col0;
#pragma unroll
                    for (int bj = 0; bj < 2; ++bj) { const f32x4 v0 = acc[ai][bj][m][0], v1 = acc[ai][bj][m][1];
                        u32x4 w; w.x = cvt_pk_bf16(v0[0], v0[1]); w.y = cvt_pk_bf16(v0[2], v0[3]); w.z = cvt_pk_bf16(v1[0], v1[1]); w.w = cvt_pk_bf16(v1[2], v1[3]);
                        *(u32x4*)(rowp + bj * HALF) = w; } }
        }
    }
};
template <bool FROM_X> struct EpiResid {
    static constexpr bool PERM = false, AFTER_DRAIN = false;
    const float* xp; const float* xs; float* h; const float* gate;
    __device__ __forceinline__ void operator()(const f32x4 (&acc)[2][2][4][2], const Unit& u, int wr, int wc, int fr, int fq) const {
        const int col0 = u.pn * BM + wc * 32 + 4 * fq;
#pragma unroll
        for (int ai = 0; ai < 2; ++ai)
#pragma unroll
            for (int m = 0; m < 4; ++m) { const int row = u.pm * BM + ai * HALF + wr * 64 + m * 16 + fr;
                const float* gt = gate + (size_t)mod_row(row) * MODLD + col0;
                const float* base = (FROM_X ? (row < NROW_PROMPT ? xp + (size_t)row * DM : xs + (size_t)(row - NROW_PROMPT) * DM) : h + (size_t)row * DM) + col0;
                float* o = h + (size_t)row * DM + col0;
#pragma unroll
                for (int bj = 0; bj < 2; ++bj)
#pragma unroll
                    for (int n = 0; n < 2; ++n) { const int off = bj * HALF + n * 16; const f32x4 b = *(const f32x4*)(base + off), g = *(const f32x4*)(gt + off);
                        *(f32x4*)(o + off) = b + g * acc[ai][bj][m][n]; }
                asm volatile("" ::: "memory"); }
    }
};
template <class Epi, class Sched, bool ALIGN_EPI = false, bool SP2 = false>
__device__ __forceinline__ void gemm_phase(PG8_LAS unsigned char* lds, const Gemm g, const Sched& S, const Epi& E) {
    const int tid = threadIdx.x, wid = __builtin_amdgcn_readfirstlane(tid >> 6), lane = tid & 63, wr = wid >> 2, wc = wid & 3, fr = lane & 15, fq = lane >> 4;
    const int K = g.K, nt = K / BK;
    unsigned voffA[2], voffB[2];
#pragma unroll
    for (int i = 0; i < 2; ++i) { int R, C; stage_rc(tid * 16 + i * 8192, R, C); const int Rb = Epi::PERM ? ((R & ~31) + perm32(R & 31)) : R;
        voffA[i] = (unsigned)(R * K + C) * 2u; voffB[i] = (unsigned)(Rb * K + C) * 2u; }
    const size_t kstep = (size_t)(BK * 2);
    const size_t hstep = (size_t)HALF * K * 2;
    const size_t tstep = 2 * hstep;
    const unsigned ldsw = (unsigned)wid * 1024u;
    const int aoff = lds_byte(wr * 64 + fr, fq * 8), boff = lds_byte(wc * 32 + fr, fq * 8);
#define PG8_SA(b, h) (((b) * 2 + (h)) * HTB)
#define PG8_SB(b, h) ((4 + (b) * 2 + (h)) * HTB)
#define PG8_STAGE(bufoff, gbase, voff) do { _Pragma("unroll") for (int _i = 0; _i < 2; ++_i) \
        __builtin_amdgcn_global_load_lds((const unsigned*)((const char*)(gbase) + (voff)[_i]), (PG8_LAS unsigned*)(lds + (bufoff) + ldsw + _i * 8192), 16, 0, 0); } while (0)
#define PG8_LDA(dst, b, h) do { _Pragma("unroll") for (int m = 0; m < 4; ++m) _Pragma("unroll") for (int k = 0; k < 2; ++k) dst[m][k] = *(const PG8_LAS bf16x8*)(lds + PG8_SA(b, h) + aoff + m * 2048 + k * 1024); } while (0)
#define PG8_LDB(dst, b, h) do { _Pragma("unroll") for (int n = 0; n < 2; ++n) _Pragma("unroll") for (int k = 0; k < 2; ++k) dst[n][k] = *(const PG8_LAS bf16x8*)(lds + PG8_SB(b, h) + boff + n * 2048 + k * 1024); } while (0)
#define PG8_MMA(ai, bj, At, Bt) do { __builtin_amdgcn_s_setprio(1); _Pragma("unroll") for (int m = 0; m < 4; ++m) _Pragma("unroll") for (int n = 0; n < 2; ++n) _Pragma("unroll") for (int k = 0; k < 2; ++k) \
        acc[ai][bj][m][n] = __builtin_amdgcn_mfma_f32_16x16x32_bf16(Bt[n][k], At[m][k], acc[ai][bj][m][n], 0, 0, 0); __builtin_amdgcn_s_setprio(0); } while (0)
#define PG8_WAIT_V(n) asm volatile("s_waitcnt vmcnt(" #n ")" ::: "memory")
#define PG8_WAIT_L(n) asm volatile("s_waitcnt lgkmcnt(" #n ")" ::: "memory")
#define PG8_BAR __builtin_amdgcn_s_barrier()
#define PG8_SCHED __builtin_amdgcn_sched_barrier(0)
    Unit cur, nxt; int ui = 0;
    if (!S.next(0, cur)) return;
    f32x4 acc[2][2][4][2];
#pragma unroll
    for (int a = 0; a < 2; ++a)
#pragma unroll
        for (int b = 0; b < 2; ++b)
#pragma unroll
            for (int m = 0; m < 4; ++m)
#pragma unroll
                for (int n = 0; n < 2; ++n) acc[a][b][m][n] = (f32x4){0.f, 0.f, 0.f, 0.f};
    bf16x8 At[4][2], B0[2][2], B1[2][2];
    const char* cA = (const char*)g.A + (size_t)cur.pm * tstep; const char* cB = (const char*)g.Bt + (size_t)cur.pn * tstep;
    S.a_ready(cur);
    if constexpr (SP2) {
        PG8_STAGE(PG8_SB(0, 0), cB, voffB); PG8_STAGE(PG8_SB(0, 1), cB + hstep, voffB); PG8_STAGE(PG8_SA(0, 0), cA, voffA); PG8_STAGE(PG8_SA(0, 1), cA + hstep, voffA);
        if (wr == 1) PG8_BAR;
        PG8_WAIT_V(2); PG8_BAR;
        PG8_STAGE(PG8_SB(1, 0), cB + kstep, voffB); PG8_STAGE(PG8_SA(1, 0), cA + kstep, voffA); PG8_STAGE(PG8_SB(1, 1), cB + hstep + kstep, voffB);
        PG8_WAIT_V(6); PG8_BAR;
    } else {
        PG8_STAGE(PG8_SB(0, 0), cB, voffB); PG8_STAGE(PG8_SA(0, 0), cA, voffA); PG8_STAGE(PG8_SB(0, 1), cB + hstep, voffB); PG8_STAGE(PG8_SA(0, 1), cA + hstep, voffA);
        if (wr == 1) PG8_BAR;
        PG8_WAIT_V(4); PG8_BAR;
        PG8_STAGE(PG8_SB(1, 0), cB + kstep, voffB); PG8_STAGE(PG8_SA(1, 0), cA + kstep, voffA); PG8_STAGE(PG8_SB(1, 1), cB + hstep + kstep, voffB);
        PG8_WAIT_V(6); PG8_BAR;
    }
    for (;;) {
        const bool has_next = S.next(ui + 1, nxt);
        const char* nA = has_next ? (const char*)g.A + (size_t)nxt.pm * tstep : cA; const char* nB = has_next ? (const char*)g.Bt + (size_t)nxt.pn * tstep : cB;
        for (int t = 0; t < nt; t += 2) {
            const bool last = (t == nt - 2);
            const char* a1 = cA + (size_t)(t + 1) * kstep;
            const char* a2 = last ? nA : cA + (size_t)(t + 2) * kstep; const char* b2 = last ? nB : cB + (size_t)(t + 2) * kstep;
            const char* a3 = a2 + kstep; const char* b3 = b2 + kstep;
            if (last && has_next) S.a_ready(nxt);
            if constexpr (SP2) {
            PG8_LDB(B0, 0, 0); PG8_LDB(B1, 0, 1); PG8_SCHED; PG8_LDA(At, 0, 0); PG8_STAGE(PG8_SA(1, 1), a1 + hstep, voffA);
            PG8_WAIT_V(8); PG8_WAIT_L(0); PG8_BAR; PG8_MMA(0, 0, At, B0); PG8_MMA(0, 1, At, B1); PG8_BAR; PG8_SCHED;
            PG8_LDA(At, 0, 1); PG8_STAGE(PG8_SB(0, 0), b2, voffB); PG8_STAGE(PG8_SB(0, 1), b2 + hstep, voffB); PG8_STAGE(PG8_SA(0, 0), a2, voffA);
            PG8_WAIT_V(8); PG8_WAIT_L(0); PG8_BAR; PG8_MMA(1, 0, At, B0); PG8_MMA(1, 1, At, B1); PG8_BAR; PG8_SCHED;
            PG8_LDB(B0, 1, 0); PG8_LDB(B1, 1, 1); PG8_SCHED; PG8_LDA(At, 1, 0); PG8_STAGE(PG8_SA(0, 1), a2 + hstep, voffA);
            PG8_WAIT_V(8); PG8_WAIT_L(0); PG8_BAR; PG8_MMA(0, 0, At, B0); PG8_MMA(0, 1, At, B1); PG8_BAR; PG8_SCHED;
            PG8_LDA(At, 1, 1); PG8_STAGE(PG8_SB(1, 0), b3, voffB); PG8_STAGE(PG8_SB(1, 1), b3 + hstep, voffB); PG8_STAGE(PG8_SA(1, 0), a3, voffA);
            PG8_WAIT_V(8); PG8_WAIT_L(0); PG8_BAR; PG8_MMA(1, 0, At, B0); PG8_MMA(1, 1, At, B1); PG8_BAR; PG8_SCHED;
            } else {
            PG8_LDB(B0, 0, 0); PG8_SCHED; PG8_LDA(At, 0, 0); PG8_STAGE(PG8_SA(1, 1), a1 + hstep, voffA);
            PG8_WAIT_L(8); PG8_BAR; PG8_WAIT_L(0); PG8_MMA(0, 0, At, B0); PG8_BAR; PG8_SCHED;
            PG8_LDB(B1, 0, 1); PG8_STAGE(PG8_SB(0, 0), b2, voffB);
            PG8_BAR; PG8_WAIT_L(0); PG8_MMA(0, 1, At, B1); PG8_BAR;
            PG8_LDA(At, 0, 1); PG8_STAGE(PG8_SA(0, 0), a2, voffA);
            PG8_BAR; PG8_WAIT_L(0); PG8_MMA(1, 0, At, B0); PG8_BAR; PG8_SCHED;
            PG8_STAGE(PG8_SB(0, 1), b2 + hstep, voffB);
            PG8_WAIT_V(6); PG8_BAR; PG8_MMA(1, 1, At, B1); PG8_BAR;
            PG8_LDB(B0, 1, 0); PG8_SCHED; PG8_LDA(At, 1, 0); PG8_STAGE(PG8_SA(0, 1), a2 + hstep, voffA);
            PG8_WAIT_L(8); PG8_BAR; PG8_WAIT_L(0); PG8_MMA(0, 0, At, B0); PG8_BAR; PG8_SCHED;
            PG8_LDB(B1, 1, 1); PG8_STAGE(PG8_SB(1, 0), b3, voffB);
            PG8_BAR; PG8_WAIT_L(0); PG8_MMA(0, 1, At, B1); PG8_BAR;
            PG8_LDA(At, 1, 1); PG8_STAGE(PG8_SA(1, 0), a3, voffA);
            PG8_BAR; PG8_WAIT_L(0); PG8_MMA(1, 0, At, B0); PG8_BAR; PG8_SCHED;
            PG8_STAGE(PG8_SB(1, 1), b3 + hstep, voffB);
            PG8_WAIT_V(6); PG8_BAR; PG8_MMA(1, 1, At, B1); PG8_BAR;
            }
        }
        if constexpr (ALIGN_EPI) { if (wr == 0) PG8_BAR; }
        if constexpr (!Epi::AFTER_DRAIN) { E(acc, cur, wr, wc, fr, fq); S.done(cur); }
        if (!has_next) break;
#pragma unroll
        for (int a = 0; a < 2; ++a)
#pragma unroll
            for (int b = 0; b < 2; ++b)
#pragma unroll
                for (int m = 0; m < 4; ++m)
#pragma unroll
                    for (int n = 0; n < 2; ++n) acc[a][b][m][n] = (f32x4){0.f, 0.f, 0.f, 0.f};
        cur = nxt; cA = nA; cB = nB; ++ui;
        if constexpr (ALIGN_EPI) { if (wr == 1) PG8_BAR; }
    }
    PG8_WAIT_V(0);
    if constexpr (!ALIGN_EPI) { if (wr == 0) PG8_BAR; }
    PG8_BAR;
    if constexpr (Epi::AFTER_DRAIN) { E.fused(acc, cur, wr, wc, fr, fq, lds, wid, lane); S.done(cur); }
#undef PG8_SA
#undef PG8_SB
#undef PG8_STAGE
#undef PG8_LDA
#undef PG8_LDB
#undef PG8_MMA
#undef PG8_WAIT_V
#undef PG8_WAIT_L
#undef PG8_BAR
#undef PG8_SCHED
}
}

#ifndef MK_MULTI_LAUNCH
#define MK_MULTI_LAUNCH 0
#endif
#define LAS __attribute__((address_space(3)))
typedef unsigned short bf16;
typedef float f32x4 __attribute__((ext_vector_type(4)));
typedef unsigned v4u __attribute__((ext_vector_type(4)));
typedef unsigned v2u __attribute__((ext_vector_type(2)));
typedef short bf16x8 __attribute__((ext_vector_type(8)));

constexpr int D = 1024, NP = 16384  , NS = 1024  , M = NP + NS, SEQ = 2048, DSEQ = 8, NBP = 8, NBS = 128, NB = NBP + NBS;
constexpr int FF = 2816, DC = 512, DP = 512, CW = 31, PM = 16, NMOD = 9, MODN = NMOD * D;
constexpr float EPS = 1e-6f;
constexpr size_t O_Y = 0, O_NSCP = (size_t)M * D, O_NSPP = O_NSCP + (size_t)NBP * 30 * DC, O_NSCS = O_NSPP + (size_t)NBP * 15 * DP, O_NSPS = O_NSCS + (size_t)NBS * 30 * DC;
constexpr size_t MiB = 1u << 20;
constexpr size_t WS_MOD = 1 * MiB;
constexpr size_t WS_WUP1 = 6 * MiB;
constexpr size_t WS_WDN1 = 17 * MiB;
constexpr size_t WS_WIN = 23 * MiB;
constexpr size_t WS_WOUT = 26 * MiB;
constexpr size_t WS_WUP2 = 28 * MiB;
constexpr size_t WS_WDN2 = 39 * MiB;
constexpr size_t WS_WADA = 45 * MiB;
constexpr size_t WS_SC = 63 * MiB;
constexpr size_t WS_A = 64 * MiB;
constexpr size_t WS_ACT = 98 * MiB;
constexpr size_t WS_END = 192 * MiB;
constexpr int LDS_BYTES = 147456;

__device__ __forceinline__ unsigned f2bf(float f) { unsigned u = __builtin_bit_cast(unsigned, f); return (u + 0x7fffu + ((u >> 16) & 1u)) >> 16; }
__device__ __forceinline__ unsigned pk2(float lo, float hi) { return f2bf(lo) | (f2bf(hi) << 16); }
__device__ __forceinline__ float bf2f(bf16 b) { return __builtin_bit_cast(float, (unsigned)b << 16); }
__device__ __forceinline__ float wave_sum(float v) {
#pragma unroll
    for (int o = 1; o < 64; o <<= 1) v += __shfl_xor(v, o);
    return v;
}
#define LDS_WAIT() asm volatile("s_waitcnt lgkmcnt(0)" ::: "memory")

struct Args { const float* in[24]; float* out; unsigned char* ws; int ph_lo, ph_hi; };
enum { I_XP = 0, I_XS, I_SCONV, I_SPOOL, I_CP, I_CS, I_WADA, I_BADA, I_G1, I_WUP1, I_WDN1, I_GM, I_WIN, I_WDW, I_BDW, I_LNG, I_LNB, I_WPOOL, I_PSCALE, I_WOUT, I_G2, I_WUP2, I_WDN2, I_GF };

__device__ __forceinline__ void transpose_item(const float* W, int ldw, bf16* WT, int ldt, int k0, int n0, int drow0, LAS float* scr, int lane) {
#pragma unroll 8
    for (int i = 0; i < 32; ++i) { const int kk = 2 * i + (lane >> 5); scr[kk * 33 + (lane & 31)] = W[(size_t)(k0 + kk) * ldw + n0 + (lane & 31)]; }
    LDS_WAIT(); asm volatile("" ::: "memory");
    const int c = lane & 7;
#pragma unroll
    for (int j = 0; j < 4; ++j) { const int n = (lane >> 3) + 8 * j; const LAS float* s = scr + (8 * c) * 33 + n;
        v4u o; o.x = pk2(s[0 * 33], s[1 * 33]); o.y = pk2(s[2 * 33], s[3 * 33]); o.z = pk2(s[4 * 33], s[5 * 33]); o.w = pk2(s[6 * 33], s[7 * 33]);
        *(v4u*)(WT + (size_t)(drow0 + n) * ldt + k0 + 8 * c) = o; }
    LDS_WAIT(); asm volatile("" ::: "memory");
}
__device__ __forceinline__ int pair_row(int n, int half) { const int sec = n >= half ? 1 : 0, j = n - sec * half; return (j >> 7) * 256 + sec * 128 + (j & 127); }

__device__ __forceinline__ void p0_prologue(const Args& a, LAS unsigned char* lds, int G) {
    const int tid = threadIdx.x, lane = tid & 63, wave = __builtin_amdgcn_readfirstlane(tid >> 6);
    unsigned char* ws = a.ws;
    LAS float* scr = (LAS float*)(lds + wave * 16384);
    const int gw = blockIdx.x * 8 + wave, NGW = G * 8;
    constexpr int I_UP = (D / 64) * (2 * FF / 32), I_DN = (FF / 64) * (D / 32), I_IN = (D / 64) * (1536 / 32), I_OUT = (512 / 64) * (D / 32), I_ADA = (D / 64) * (MODN / 32);
    constexpr int NITEMS = 2 * I_UP + 2 * I_DN + I_IN + I_OUT + I_ADA;
    for (int it = gw; it < NITEMS; it += NGW) {
        int r = it;
        if (r < I_ADA) { const int nblk = MODN / 32, kb = r / nblk, nb = r % nblk; transpose_item(a.in[I_WADA], MODN, (bf16*)(ws + WS_WADA), D, kb * 64, nb * 32, nb * 32, scr, lane); continue; } r -= I_ADA;
        if (r < 2 * I_UP) { const int l = r >= I_UP; r -= l * I_UP; const int nblk = 2 * FF / 32, kb = r / nblk, nb = r % nblk;
            transpose_item(a.in[l ? I_WUP2 : I_WUP1], 2 * FF, (bf16*)(ws + (l ? WS_WUP2 : WS_WUP1)), D, kb * 64, nb * 32, pair_row(nb * 32, FF), scr, lane); continue; } r -= 2 * I_UP;
        if (r < 2 * I_DN) { const int l = r >= I_DN; r -= l * I_DN; const int nblk = D / 32, kb = r / nblk, nb = r % nblk;
            transpose_item(a.in[l ? I_WDN2 : I_WDN1], D, (bf16*)(ws + (l ? WS_WDN2 : WS_WDN1)), FF, kb * 64, nb * 32, nb * 32, scr, lane); continue; } r -= 2 * I_DN;
        if (r < I_IN) { const int nblk = 1536 / 32, kb = r / nblk, nb = r % nblk, n0 = nb * 32;
            transpose_item(a.in[I_WIN], 1536, (bf16*)(ws + WS_WIN), D, kb * 64, n0, n0 < 1024 ? pair_row(n0, 512) : n0, scr, lane); continue; } r -= I_IN;
        { const int nblk = D / 32, kb = r / nblk, nb = r % nblk; transpose_item(a.in[I_WOUT], D, (bf16*)(ws + WS_WOUT), D, kb * 64, nb * 32, nb * 32, scr, lane); }
    }
    const int gt = blockIdx.x * 512 + tid, NGT = G * 512;
    for (int i = gt; i < 144 * D / 4; i += NGT) { const int row = i / (D / 4), c4 = i % (D / 4);
        f32x4 v = (f32x4){0.f, 0.f, 0.f, 0.f};
        if (row < NBP) v = *(const f32x4*)(a.in[I_CP] + (size_t)row * D + c4 * 4); else if (row < NB) v = *(const f32x4*)(a.in[I_CS] + (size_t)(row - NBP) * D + c4 * 4);
        v2u o; o.x = pk2(v[0] * pg8::sigmoid_f(v[0]), v[1] * pg8::sigmoid_f(v[1])); o.y = pk2(v[2] * pg8::sigmoid_f(v[2]), v[3] * pg8::sigmoid_f(v[3]));
        *(v2u*)((bf16*)(ws + WS_SC) + (size_t)row * D + c4 * 4) = o; }
    for (int it = gt; it < 1024 * 64; it += NGT) { const int n = it & 1023, gc = it >> 10, g = gc >> 4, c8 = gc & 15;
        float acc[8];
#pragma unroll
        for (int i = 0; i < 8; ++i) acc[i] = 0.f;
        const float* wo = a.in[I_WOUT] + (size_t)(512 + 128 * g) * D + n; const float* ps = a.in[I_PSCALE] + 128 * g; const float* wp = a.in[I_WPOOL] + (size_t)(g * 128 + c8 * 8) * 128;
#pragma unroll 4
        for (int d = 0; d < 128; ++d) { const float w = wo[(size_t)d * D] * ps[d];
#pragma unroll
            for (int i = 0; i < 8; ++i) acc[i] = __builtin_fmaf(wp[i * 128 + d], w, acc[i]); }
        v4u o; o.x = pk2(acc[0], acc[1]); o.y = pk2(acc[2], acc[3]); o.z = pk2(acc[4], acc[5]); o.w = pk2(acc[6], acc[7]);
        *(v4u*)((bf16*)(ws + WS_WOUT) + (size_t)n * D + 512 + 128 * g + c8 * 8) = o; }
}

__device__ __forceinline__ void p1_mod(const Args& a, int G) {
    const int tid = threadIdx.x, lane = tid & 63, wave = __builtin_amdgcn_readfirstlane(tid >> 6), fr = lane & 15, fq = lane >> 4;
    const bf16* Wt = (const bf16*)(a.ws + WS_WADA); const bf16* SC = (const bf16*)(a.ws + WS_SC); float* mod = (float*)(a.ws + WS_MOD);
    const int gw = blockIdx.x * 8 + wave, NGW = G * 8;
    for (int item = gw; item < (MODN / 16) * 3; item += NGW) {
        const int nt = item / 3, bg = item % 3, n0 = nt * 16, b0 = bg * 48;
        f32x4 acc[3];
#pragma unroll
        for (int i = 0; i < 3; ++i) acc[i] = (f32x4){0.f, 0.f, 0.f, 0.f};
        const bf16* wp = Wt + (size_t)(n0 + fr) * D + fq * 8; const bf16* sp = SC + (size_t)(b0 + fr) * D + fq * 8;
#pragma unroll 4
        for (int ks = 0; ks < D / 32; ++ks) { const bf16x8 wf = *(const bf16x8*)(wp + ks * 32);
#pragma unroll
            for (int i = 0; i < 3; ++i) { const bf16x8 sf = *(const bf16x8*)(sp + (size_t)i * 16 * D + ks * 32); acc[i] = __builtin_amdgcn_mfma_f32_16x16x32_bf16(wf, sf, acc[i], 0, 0, 0); } }
        const int n = n0 + 4 * fq, slot = n >> 10, col = n & 1023, kind = slot % 3;
        const f32x4 bias = *(const f32x4*)(a.in[I_BADA] + n);
        f32x4 gv = (f32x4){1.f, 1.f, 1.f, 1.f};
        if (kind == 1) gv = *(const f32x4*)(a.in[slot == 1 ? I_G1 : (slot == 4 ? I_GM : I_G2)] + col);
        const float gs = (slot == 2 || slot == 8) ? 0.5f : 1.0f;
#pragma unroll
        for (int i = 0; i < 3; ++i) { const int b = b0 + 16 * i + fr; f32x4 v = acc[i] + bias;
            if (kind == 1) v = gv * (v + 1.0f); else if (kind == 2) v = v * gs;
            if (b < NB) *(f32x4*)(mod + (size_t)b * MODN + n) = v; }
    }
}

template <bool FROM_X> __device__ __forceinline__ void norm_phase(const Args& a, int G, int slot_shift) {
    const int tid = threadIdx.x, lane = tid & 63, wave = __builtin_amdgcn_readfirstlane(tid >> 6);
    const float* mod = (const float*)(a.ws + WS_MOD); bf16* A = (bf16*)(a.ws + WS_A);
    const int gw = blockIdx.x * 8 + wave, NGW = G * 8;
    for (int row = gw; row < M; row += NGW) {
        const float* src = FROM_X ? (row < NP ? a.in[I_XP] + (size_t)row * D : a.in[I_XS] + (size_t)(row - NP) * D) : a.out + (size_t)row * D;
        const f32x4* xr = (const f32x4*)src + lane;
        f32x4 v[4]; float s = 0.f;
#pragma unroll
        for (int j = 0; j < 4; ++j) { v[j] = xr[64 * j]; s += (v[j].x * v[j].x + v[j].y * v[j].y) + (v[j].z * v[j].z + v[j].w * v[j].w); }
        const float r = 1.0f / sqrtf(wave_sum(s) * (1.0f / D) + EPS);
        const float* mrow = mod + (size_t)pg8::mod_row(row) * MODN + (size_t)slot_shift * D;
        const f32x4* sh = (const f32x4*)mrow + lane; const f32x4* cs = (const f32x4*)(mrow + D) + lane;
        v2u* o8 = (v2u*)(A + (size_t)row * D) + lane;
#pragma unroll
        for (int j = 0; j < 4; ++j) { const f32x4 c = cs[64 * j], h = sh[64 * j]; const f32x4 y = v[j] * r * c + h; v2u o; o.x = pk2(y.x, y.y); o.y = pk2(y.z, y.w); o8[64 * j] = o; }
    }
}
__device__ __forceinline__ void final_norm_phase(const Args& a, int G) {
    const int tid = threadIdx.x, lane = tid & 63, wave = __builtin_amdgcn_readfirstlane(tid >> 6);
    const int gw = blockIdx.x * 8 + wave, NGW = G * 8;
    const f32x4* gf = (const f32x4*)a.in[I_GF] + lane;
    for (int row = gw; row < M; row += NGW) {
        f32x4* xr = (f32x4*)(a.out + (size_t)row * D) + lane;
        f32x4 v[4]; float s = 0.f;
#pragma unroll
        for (int j = 0; j < 4; ++j) { v[j] = xr[64 * j]; s += (v[j].x * v[j].x + v[j].y * v[j].y) + (v[j].z * v[j].z + v[j].w * v[j].w); }
        const float r = 1.0f / sqrtf(wave_sum(s) * (1.0f / D) + EPS);
#pragma unroll
        for (int j = 0; j < 4; ++j) xr[64 * j] = v[j] * r * gf[64 * j];
    }
}

__device__ __forceinline__ void mixer_phase(const Args& a, LAS unsigned char* lds, int G) {
    const int tid = threadIdx.x, lane = tid & 63, wave = __builtin_amdgcn_readfirstlane(tid >> 6), c = tid;
    const bf16* U = (const bf16*)(a.ws + WS_ACT); bf16* A = (bf16*)(a.ws + WS_A);
    LAS float* vbuf = (LAS float*)lds;
    float wdw[CW];
#pragma unroll
    for (int k = 0; k < CW; ++k) wdw[k] = a.in[I_WDW][k * DC + c];
    const float bdw = a.in[I_BDW][c];
    const int gi = c >> 7, win = 2 << gi;
    for (int uidx = blockIdx.x; uidx < M / 8; uidx += G) {
        const bool prompt = uidx < NP / 8;
        const int b = prompt ? uidx / (SEQ / 8) : uidx - NP / 8, t0 = prompt ? (uidx % (SEQ / 8)) * 8 : 0, row0 = prompt ? b * SEQ + t0 : NP + b * 8;
        float in[38];
        if (prompt) {
#pragma unroll
            for (int i = 0; i < 38; ++i) in[i] = (t0 - 30 + i >= 0) ? bf2f(U[(size_t)(row0 - 30 + i) * D + c]) : 0.f;
        } else {
            const float* st = a.in[I_SCONV] + (size_t)b * 30 * DC + c;
#pragma unroll
            for (int i = 0; i < 30; ++i) in[i] = st[i * DC];
#pragma unroll
            for (int i = 30; i < 38; ++i) in[i] = bf2f(U[(size_t)(row0 + i - 30) * D + c]);
        }
#pragma unroll
        for (int tt = 0; tt < 8; ++tt) { float s = bdw;
#pragma unroll
            for (int k = 0; k < CW; ++k) s = __builtin_fmaf(wdw[k], in[tt + k], s);
            vbuf[tt * DC + c] = s; }
        if (prompt) { if (t0 + 8 > SEQ - 30) {
#pragma unroll
                for (int tt = 0; tt < 8; ++tt) if (t0 + tt >= SEQ - 30) a.out[O_NSCP + (size_t)(b * 30 + t0 + tt - (SEQ - 30)) * DC + c] = in[30 + tt]; }
        } else { float* o = a.out + O_NSCS + (size_t)b * 30 * DC + c;
#pragma unroll
            for (int e = 8; e < 38; ++e) o[(e - 8) * DC] = in[e]; }
        float pin[23];
        if (prompt) {
#pragma unroll
            for (int i = 0; i < 23; ++i) pin[i] = (t0 - 15 + i >= 0) ? bf2f(U[(size_t)(row0 - 15 + i) * D + DC + c]) : 0.f;
        } else {
            const float* st = a.in[I_SPOOL] + (size_t)b * 15 * DP + c;
#pragma unroll
            for (int i = 0; i < 15; ++i) pin[i] = st[i * DP];
#pragma unroll
            for (int i = 15; i < 23; ++i) pin[i] = bf2f(U[(size_t)(row0 + i - 15) * D + DC + c]);
        }
#pragma unroll
        for (int tt = 0; tt < 8; ++tt) { const float cur = pin[15 + tt];
            const float s2 = cur + pin[14 + tt], s4 = s2 + (pin[13 + tt] + pin[12 + tt]), s8 = s4 + ((pin[11 + tt] + pin[10 + tt]) + (pin[9 + tt] + pin[8 + tt]));
            const float s16 = s8 + (((pin[7 + tt] + pin[6 + tt]) + (pin[5 + tt] + pin[4 + tt])) + ((pin[3 + tt] + pin[2 + tt]) + (pin[1 + tt] + pin[0 + tt])));
            const float s = gi == 0 ? s2 : (gi == 1 ? s4 : (gi == 2 ? s8 : s16));
            const int cnt = prompt ? (t0 + tt + 1 < win ? t0 + tt + 1 : win) : win;
            A[(size_t)(row0 + tt) * D + DC + c] = (bf16)f2bf(s / (float)cnt - cur); }
        if (prompt) { if (t0 + 8 > SEQ - 15) {
#pragma unroll
                for (int tt = 0; tt < 8; ++tt) if (t0 + tt >= SEQ - 15) a.out[O_NSPP + (size_t)(b * 15 + t0 + tt - (SEQ - 15)) * DP + c] = pin[15 + tt]; }
        } else { float* o = a.out + O_NSPS + (size_t)b * 15 * DP + c;
#pragma unroll
            for (int e = 8; e < 23; ++e) o[(e - 8) * DP] = pin[e]; }
        LDS_WAIT(); __syncthreads();
        { const LAS float* vr = vbuf + wave * DC + lane * 8; const f32x4 x0 = *(const LAS f32x4*)vr, x1 = *(const LAS f32x4*)(vr + 4);
            const float mean = wave_sum((x0.x + x0.y) + (x0.z + x0.w) + (x1.x + x1.y) + (x1.z + x1.w)) * (1.0f / DC);
            const f32x4 d0 = x0 - mean, d1 = x1 - mean;
            const float var = wave_sum((d0.x * d0.x + d0.y * d0.y) + (d0.z * d0.z + d0.w * d0.w) + (d1.x * d1.x + d1.y * d1.y) + (d1.z * d1.z + d1.w * d1.w)) * (1.0f / DC);
            const float rstd = 1.0f / sqrtf(var + EPS);
            const f32x4 g0 = *(const f32x4*)(a.in[I_LNG] + lane * 8), g1 = *(const f32x4*)(a.in[I_LNG] + lane * 8 + 4), b0 = *(const f32x4*)(a.in[I_LNB] + lane * 8), b1 = *(const f32x4*)(a.in[I_LNB] + lane * 8 + 4);
            f32x4 y0 = d0 * rstd * g0 + b0, y1 = d1 * rstd * g1 + b1;
#pragma unroll
            for (int j = 0; j < 4; ++j) { y0[j] = y0[j] * pg8::sigmoid_f(y0[j]); y1[j] = y1[j] * pg8::sigmoid_f(y1[j]); }
            v4u o; o.x = pk2(y0.x, y0.y); o.y = pk2(y0.z, y0.w); o.z = pk2(y1.x, y1.y); o.w = pk2(y1.z, y1.w);
            *(v4u*)(A + (size_t)(row0 + wave) * D + lane * 8) = o; }
        LDS_WAIT(); __syncthreads();
    }
}

constexpr int N_PHASES = 13;
__global__ void __launch_bounds__(512, 2) fwd_megakernel(Args args) {
    extern __shared__ __attribute__((aligned(16))) unsigned char lds_raw[];
    LAS unsigned char* lds = (LAS unsigned char*)lds_raw;
    const int G = gridDim.x, lo = args.ph_lo, hi = args.ph_hi;
    unsigned char* ws = args.ws;
    float* mod = (float*)(ws + WS_MOD);
    bf16* Abuf = (bf16*)(ws + WS_A); bf16* ACT = (bf16*)(ws + WS_ACT);
#define IN(k) (lo <= (k) && (k) < hi)
#if MK_MULTI_LAUNCH
#define SEAM(k) do { } while (0)
#else
#define SEAM(k) do { if (IN(k) && IN((k) + 1)) cg::this_grid().sync(); } while (0)
#endif
    if (IN(0)) { p0_prologue(args, lds, G); } SEAM(0);
    if (IN(1)) { p1_mod(args, G); } SEAM(1);
    if (IN(2)) { norm_phase<true>(args, G, 0); } SEAM(2);
    if (IN(3)) { pg8::Gemm g{Abuf, (const bf16*)(ws + WS_WUP1), M, 2 * FF, D}; pg8::StaticOrder S; S.init(M, 2 * FF, G, (int)blockIdx.x);
        pg8::EpiGate<0> E{ACT, FF}; pg8::gemm_phase<pg8::EpiGate<0>, pg8::StaticOrder, true, true>(lds, g, S, E); } SEAM(3);
    if (IN(4)) { pg8::Gemm g{ACT, (const bf16*)(ws + WS_WDN1), M, D, FF}; pg8::StaticOrder S; S.init(M, D, G, (int)blockIdx.x);
        pg8::EpiResid<true> E{args.in[I_XP], args.in[I_XS], args.out, mod + 2 * D}; pg8::gemm_phase<pg8::EpiResid<true>, pg8::StaticOrder, true, true>(lds, g, S, E); } SEAM(4);
    if (IN(5)) { norm_phase<false>(args, G, 3); } SEAM(5);
    if (IN(6)) { pg8::Gemm g{Abuf, (const bf16*)(ws + WS_WIN), M, 1536, D}; pg8::StaticOrder S; S.init(M, 1536, G, (int)blockIdx.x);
        pg8::EpiGate<1> E{ACT, D}; pg8::gemm_phase<pg8::EpiGate<1>, pg8::StaticOrder, true, true>(lds, g, S, E); } SEAM(6);
    if (IN(7)) { mixer_phase(args, lds, G); } SEAM(7);
    if (IN(8)) { pg8::Gemm g{Abuf, (const bf16*)(ws + WS_WOUT), M, D, D}; pg8::StaticOrder S; S.init(M, D, G, (int)blockIdx.x);
        pg8::EpiResid<false> E{nullptr, nullptr, args.out, mod + 5 * D}; pg8::gemm_phase<pg8::EpiResid<false>, pg8::StaticOrder, true, true>(lds, g, S, E); } SEAM(8);
    if (IN(9)) { norm_phase<false>(args, G, 6); } SEAM(9);
    if (IN(10)) { pg8::Gemm g{Abuf, (const bf16*)(ws + WS_WUP2), M, 2 * FF, D}; pg8::StaticOrder S; S.init(M, 2 * FF, G, (int)blockIdx.x);
        pg8::EpiGate<0> E{ACT, FF}; pg8::gemm_phase<pg8::EpiGate<0>, pg8::StaticOrder, true, true>(lds, g, S, E); } SEAM(10);
    if (IN(11)) { pg8::Gemm g{ACT, (const bf16*)(ws + WS_WDN2), M, D, FF}; pg8::StaticOrder S; S.init(M, D, G, (int)blockIdx.x);
        pg8::EpiResid<false> E{nullptr, nullptr, args.out, mod + 8 * D}; pg8::gemm_phase<pg8::EpiResid<false>, pg8::StaticOrder, true, true>(lds, g, S, E); } SEAM(11);
    if (IN(12)) { final_norm_phase(args, G); }
#undef IN
#undef SEAM
}

extern "C" void kernel_launch(void* const* d_in, const int* in_sizes, int n_in, void* d_out, int out_size, void* d_ws, size_t ws_size, hipStream_t stream) {
    static int grid = 0;
    if (grid == 0) {
        if (n_in != 24 || ws_size < WS_END) { fprintf(stderr, "kernel_launch: unexpected n_in %d / ws %zu\n", n_in, ws_size); grid = -1; return; }
        int dev = 0, cus = 0, per_cu = 0;
        (void)hipGetDevice(&dev); (void)hipDeviceGetAttribute(&cus, hipDeviceAttributeMultiprocessorCount, dev);
        if (hipFuncSetAttribute((const void*)fwd_megakernel, hipFuncAttributeMaxDynamicSharedMemorySize, LDS_BYTES) != hipSuccess) { fprintf(stderr, "kernel_launch: hipFuncSetAttribute failed\n"); grid = -1; return; }
        if (hipOccupancyMaxActiveBlocksPerMultiprocessor(&per_cu, (const void*)fwd_megakernel, 512, LDS_BYTES) != hipSuccess || per_cu < 1) { fprintf(stderr, "kernel_launch: occupancy query says %d blocks/CU\n", per_cu); per_cu = 1; (void)hipGetLastError(); }
        grid = cus;
        if (grid <= 0) grid = 256;
    }
    if (grid < 0) return;
    Args a{};
    for (int i = 0; i < 24; ++i) a.in[i] = (const float*)d_in[i];
    a.out = (float*)d_out; a.ws = (unsigned char*)d_ws;
#if MK_MULTI_LAUNCH
    for (int ph = 0; ph < N_PHASES; ++ph) { a.ph_lo = ph; a.ph_hi = ph + 1; hipLaunchKernelGGL(fwd_megakernel, dim3(grid), dim3(512), LDS_BYTES, stream, a); }
#else
    a.ph_lo = 0; a.ph_hi = N_PHASES;
    void* kargs[] = {&a};
    hipError_t e = hipLaunchCooperativeKernel((const void*)fwd_megakernel, dim3(grid), dim3(512), kargs, LDS_BYTES, stream);
    if (e != hipSuccess) fprintf(stderr, "kernel_launch: cooperative launch failed: %s (grid %d)\n", hipGetErrorString(e), grid);
#endif
}
```

```cpp
#include <hip/hip_runtime.h>
#include <hip/hip_cooperative_groups.h>
#include <cstdio>
#include <cstdint>
namespace cg = cooperative_groups;
#define MK_MULTI_LAUNCH 0
namespace pg8 {
#define PG8_LAS __attribute__((address_space(3)))
typedef unsigned short bf16_t;
typedef short bf16x8 __attribute__((ext_vector_type(8)));
typedef float f32x4 __attribute__((ext_vector_type(4)));
typedef unsigned u32x4 __attribute__((ext_vector_type(4)));
constexpr int BM = 256, BK = 64, HALF = 128, HTB = HALF * BK * 2  , STAGE_BYTES = 8 * HTB, NXCD = 8, WGM = 8;

__host__ __device__ __forceinline__ int lds_byte(int r, int c) { const int st = (r >> 4) * 2 + (c >> 5), rr = r & 15, cc = c & 31, ob = rr * 64 + cc * 2; return st * 1024 + (ob ^ (((ob >> 9) & 1) << 5)); }
__host__ __device__ __forceinline__ void stage_rc(int b, int& R, int& C) { const int st = b / 1024, sb = b % 1024, swz = sb ^ (((sb >> 9) & 1) << 5); R = (st >> 1) * 16 + swz / 64; C = (st & 1) * 32 + (swz % 64) / 2; }
__host__ __device__ __forceinline__ int perm32(int rho) { const int n = rho >> 4, i = rho & 15; return 8 * (i >> 2) + 4 * n + (i & 3); }

struct Unit { int pm, pn; };
struct Gemm { const bf16_t* A; const bf16_t* Bt; int M, N, K; };

struct StaticOrder {
    int nM, nN, nwg, G, c;
    __host__ __device__ void init(int M, int N, int G_, int c_) { nM = M / BM; nN = N / BM; nwg = nM * nN; G = G_; c = c_; }
    __host__ __device__ bool next(int i, Unit& u) const {
        const long L = (long)i * G + c; if (L >= nwg) return false;
        int wgid = (int)L; { const int q = nwg / NXCD, r = nwg % NXCD, xcd = wgid % NXCD, off = wgid / NXCD; wgid = (xcd < r ? xcd * (q + 1) : r * (q + 1) + (xcd - r) * q) + off; }
        const int nig = WGM * nN, gid = wgid / nig, fm = gid * WGM, gsz = (nM - fm) < WGM ? (nM - fm) : WGM;
        u.pm = fm + ((wgid % nig) % gsz); u.pn = (wgid % nig) / gsz; return true;
    }
    __device__ __forceinline__ void a_ready(const Unit&) const {}
    __device__ __forceinline__ void done(const Unit&) const {}
};

__device__ __forceinline__ unsigned cvt_pk_bf16(float lo, float hi) { unsigned r; asm volatile("v_cvt_pk_bf16_f32 %0, %1, %2" : "=v"(r) : "v"(lo), "v"(hi)); return r; }
typedef float f32x2 __attribute__((ext_vector_type(2)));
constexpr int NROW_PROMPT = 16384, MODLD = 9216, DM = 1024;
__device__ __forceinline__ int mod_row(int r) { return r < NROW_PROMPT ? (r >> 11) : 8 + ((r - NROW_PROMPT) >> 3); }
__device__ __forceinline__ float sigmoid_f(float g) { return __builtin_amdgcn_rcpf(1.0f + __builtin_amdgcn_exp2f(-1.44269504089f * g)); }

template <int MODE> struct EpiGate {
    static constexpr bool PERM = true, AFTER_DRAIN = false;
    bf16_t* O; int ldc;
    __device__ __forceinline__ void operator()(const f32x4 (&acc)[2][2][4][2], const Unit& u, int wr, int wc, int fr, int fq) const {
        const int row0 = u.pm * BM + wr * 64 + fr;
        if (MODE == 0 || u.pn < 4) {
            const int col0 = u.pn * 128 + wc * 32 + 8 * fq;
#pragma unroll
            for (int ai = 0; ai < 2; ++ai)
#pragma unroll
                for (int m = 0; m < 4; ++m) { bf16_t* rowp = O + (size_t)(row0 + ai * HALF + m * 16) * ldc + col0;
                    float o[8];
#pragma unroll
                    for (int n = 0; n < 2; ++n)
#pragma unroll
                        for (int j = 0; j < 4; ++j) { const float a = acc[ai][0][m][n][j], b = acc[ai][1][m][n][j];
                            o[n * 4 + j] = (MODE == 0) ? a * sigmoid_f(a) * b : a * sigmoid_f(b); }
                    u32x4 w; w.x = cvt_pk_bf16(o[0], o[1]); w.y = cvt_pk_bf16(o[2], o[3]); w.z = cvt_pk_bf16(o[4], o[5]); w.w = cvt_pk_bf16(o[6], o[7]);
                    *(u32x4*)rowp = w; }
        } else {
            const int col0 = 512 + (u.pn - 4) * 256 + wc * 32 + 8 * fq;
#pragma unroll
            for (int ai = 0; ai < 2; ++ai)
#pragma unroll
                for (int m = 0; m < 4; ++m) { bf16_t* rowp = O + (size_t)(row0 + ai * HALF + m * 16) * ldc + col0;
#pragma unroll
                    for (int bj = 0; bj < 2; ++bj) { const f32x4 v0 = acc[ai][bj][m][0], v1 = acc[ai][bj][m][1];
                        u32x4 w; w.x = cvt_pk_bf16(v0[0], v0[1]); w.y = cvt_pk_bf16(v0[2], v0[3]); w.z = cvt_pk_bf16(v1[0], v1[1]); w.w = cvt_pk_bf16(v1[2], v1[3]);
                        *(u32x4*)(rowp + bj * HALF) = w; } }
        }
    }
};
template <bool FROM_X> struct EpiResid {
    static constexpr bool PERM = false, AFTER_DRAIN = false;
    const float* xp; const float* xs; float* h; const float* gate;
    __device__ __forceinline__ void operator()(const f32x4 (&acc)[2][2][4][2], const Unit& u, int wr, int wc, int fr, int fq) const {
        const int col0 = u.pn * BM + wc * 32 + 4 * fq;
#pragma unroll
        for (int ai = 0; ai < 2; ++ai)
#pragma unroll
            for (int m = 0; m < 4; ++m) { const int row = u.pm * BM + ai * HALF + wr * 64 + m * 16 + fr;
                const float* gt = gate + (size_t)mod_row(row) * MODLD + col0;
                const float* base = (FROM_X ? (row < NROW_PROMPT ? xp + (size_t)row * DM : xs + (size_t)(row - NROW_PROMPT) * DM) : h + (size_t)row * DM) + col0;
                float* o = h + (size_t)row * DM + col0;
#pragma unroll
                for (int bj = 0; bj < 2; ++bj)
#pragma unroll
                    for (int n = 0; n < 2; ++n) { const int off = bj * HALF + n * 16; const f32x4 b = *(const f32x4*)(base + off), g = *(const f32x4*)(gt + off);
                        *(f32x4*)(o + off) = b + g * acc[ai][bj][m][n]; }
                asm volatile("" ::: "memory"); }
    }
};
template <class Epi, class Sched, bool ALIGN_EPI = false, bool SP2 = false>
__device__ __forceinline__ void gemm_phase(PG8_LAS unsigned char* lds, const Gemm g, const Sched& S, const Epi& E) {
    const int tid = threadIdx.x, wid = __builtin_amdgcn_readfirstlane(tid >> 6), lane = tid & 63, wr = wid >> 2, wc = wid & 3, fr = lane & 15, fq = lane >> 4;
    const int K = g.K, nt = K / BK;
    unsigned voffA[2], voffB[2];
#pragma unroll
    for (int i = 0; i < 2; ++i) { int R, C; stage_rc(tid * 16 + i * 8192, R, C); const int Rb = Epi::PERM ? ((R & ~31) + perm32(R & 31)) : R;
        voffA[i] = (unsigned)(R * K + C) * 2u; voffB[i] = (unsigned)(Rb * K + C) * 2u; }
    const size_t kstep = (size_t)(BK * 2);
    const size_t hstep = (size_t)HALF * K * 2;
    const size_t tstep = 2 * hstep;
    const unsigned ldsw = (unsigned)wid * 1024u;
    const int aoff = lds_byte(wr * 64 + fr, fq * 8), boff = lds_byte(wc * 32 + fr, fq * 8);
#define PG8_SA(b, h) (((b) * 2 + (h)) * HTB)
#define PG8_SB(b, h) ((4 + (b) * 2 + (h)) * HTB)
#define PG8_STAGE(bufoff, gbase, voff) do { _Pragma("unroll") for (int _i = 0; _i < 2; ++_i) \
        __builtin_amdgcn_global_load_lds((const unsigned*)((const char*)(gbase) + (voff)[_i]), (PG8_LAS unsigned*)(lds + (bufoff) + ldsw + _i * 8192), 16, 0, 0); } while (0)
#define PG8_LDA(dst, b, h) do { _Pragma("unroll") for (int m = 0; m < 4; ++m) _Pragma("unroll") for (int k = 0; k < 2; ++k) dst[m][k] = *(const PG8_LAS bf16x8*)(lds + PG8_SA(b, h) + aoff + m * 2048 + k * 1024); } while (0)
#define PG8_LDB(dst, b, h) do { _Pragma("unroll") for (int n = 0; n < 2; ++n) _Pragma("unroll") for (int k = 0; k < 2; ++k) dst[n][k] = *(const PG8_LAS bf16x8*)(lds + PG8_SB(b, h) + boff + n * 2048 + k * 1024); } while (0)
#define PG8_MMA(ai, bj, At, Bt) do { __builtin_amdgcn_s_setprio(1); _Pragma("unroll") for (int m = 0; m < 4; ++m) _Pragma("unroll") for (int n = 0; n < 2; ++n) _Pragma("unroll") for (int k = 0; k < 2; ++k) \
        acc[ai][bj][m][n] = __builtin_amdgcn_mfma_f32_16x16x32_bf16(Bt[n][k], At[m][k], acc[ai][bj][m][n], 0, 0, 0); __builtin_amdgcn_s_setprio(0); } while (0)
#define PG8_WAIT_V(n) asm volatile("s_waitcnt vmcnt(" #n ")" ::: "memory")
#define PG8_WAIT_L(n) asm volatile("s_waitcnt lgkmcnt(" #n ")" ::: "memory")
#define PG8_BAR __builtin_amdgcn_s_barrier()
#define PG8_SCHED __builtin_amdgcn_sched_barrier(0)
    Unit cur, nxt; int ui = 0;
    if (!S.next(0, cur)) return;
    f32x4 acc[2][2][4][2];
#pragma unroll
    for (int a = 0; a < 2; ++a)
#pragma unroll
        for (int b = 0; b < 2; ++b)
#pragma unroll
            for (int m = 0; m < 4; ++m)
#pragma unroll
                for (int n = 0; n < 2; ++n) acc[a][b][m][n] = (f32x4){0.f, 0.f, 0.f, 0.f};
    bf16x8 At[4][2], B0[2][2], B1[2][2];
    const char* cA = (const char*)g.A + (size_t)cur.pm * tstep; const char* cB = (const char*)g.Bt + (size_t)cur.pn * tstep;
    S.a_ready(cur);
    if constexpr (SP2) {
        PG8_STAGE(PG8_SB(0, 0), cB, voffB); PG8_STAGE(PG8_SB(0, 1), cB + hstep, voffB); PG8_STAGE(PG8_SA(0, 0), cA, voffA); PG8_STAGE(PG8_SA(0, 1), cA + hstep, voffA);
        if (wr == 1) PG8_BAR;
        PG8_WAIT_V(2); PG8_BAR;
        PG8_STAGE(PG8_SB(1, 0), cB + kstep, voffB); PG8_STAGE(PG8_SA(1, 0), cA + kstep, voffA); PG8_STAGE(PG8_SB(1, 1), cB + hstep + kstep, voffB);
        PG8_WAIT_V(6); PG8_BAR;
    } else {
        PG8_STAGE(PG8_SB(0, 0), cB, voffB); PG8_STAGE(PG8_SA(0, 0), cA, voffA); PG8_STAGE(PG8_SB(0, 1), cB + hstep, voffB); PG8_STAGE(PG8_SA(0, 1), cA + hstep, voffA);
        if (wr == 1) PG8_BAR;
        PG8_WAIT_V(4); PG8_BAR;
        PG8_STAGE(PG8_SB(1, 0), cB + kstep, voffB); PG8_STAGE(PG8_SA(1, 0), cA + kstep, voffA); PG8_STAGE(PG8_SB(1, 1), cB + hstep + kstep, voffB);
        PG8_WAIT_V(6); PG8_BAR;
    }
    for (;;) {
        const bool has_next = S.next(ui + 1, nxt);
        const char* nA = has_next ? (const char*)g.A + (size_t)nxt.pm * tstep : cA; const char* nB = has_next ? (const char*)g.Bt + (size_t)nxt.pn * tstep : cB;
        for (int t = 0; t < nt; t += 2) {
            const bool last = (t == nt - 2);
            const char* a1 = cA + (size_t)(t + 1) * kstep;
            const char* a2 = last ? nA : cA + (size_t)(t + 2) * kstep; const char* b2 = last ? nB : cB + (size_t)(t + 2) * kstep;
            const char* a3 = a2 + kstep; const char* b3 = b2 + kstep;
            if (last && has_next) S.a_ready(nxt);
            if constexpr (SP2) {
            PG8_LDB(B0, 0, 0); PG8_LDB(B1, 0, 1); PG8_SCHED; PG8_LDA(At, 0, 0); PG8_STAGE(PG8_SA(1, 1), a1 + hstep, voffA);
            PG8_WAIT_V(8); PG8_WAIT_L(0); PG8_BAR; PG8_MMA(0, 0, At, B0); PG8_MMA(0, 1, At, B1); PG8_BAR; PG8_SCHED;
            PG8_LDA(At, 0, 1); PG8_STAGE(PG8_SB(0, 0), b2, voffB); PG8_STAGE(PG8_SB(0, 1), b2 + hstep, voffB); PG8_STAGE(PG8_SA(0, 0), a2, voffA);
            PG8_WAIT_V(8); PG8_WAIT_L(0); PG8_BAR; PG8_MMA(1, 0, At, B0); PG8_MMA(1, 1, At, B1); PG8_BAR; PG8_SCHED;
            PG8_LDB(B0, 1, 0); PG8_LDB(B1, 1, 1); PG8_SCHED; PG8_LDA(At, 1, 0); PG8_STAGE(PG8_SA(0, 1), a2 + hstep, voffA);
            PG8_WAIT_V(8); PG8_WAIT_L(0); PG8_BAR; PG8_MMA(0, 0, At, B0); PG8_MMA(0, 1, At, B1); PG8_BAR; PG8_SCHED;
            PG8_LDA(At, 1, 1); PG8_STAGE(PG8_SB(1, 0), b3, voffB); PG8_STAGE(PG8_SB(1, 1), b3 + hstep, voffB); PG8_STAGE(PG8_SA(1, 0), a3, voffA);
            PG8_WAIT_V(8); PG8_WAIT_L(0); PG8_BAR; PG8_MMA(1, 0, At, B0); PG8_MMA(1, 1, At, B1); PG8_BAR; PG8_SCHED;
            } else {
            PG8_LDB(B0, 0, 0); PG8_SCHED; PG8_LDA(At, 0, 0); PG8_STAGE(PG8_SA(1, 1), a1 + hstep, voffA);
            PG8_WAIT_L(8); PG8_BAR; PG8_WAIT_L(0); PG8_MMA(0, 0, At, B0); PG8_BAR; PG8_SCHED;
            PG8_LDB(B1, 0, 1); PG8_STAGE(PG8_SB(0, 0), b2, voffB);
            PG8_BAR; PG8_WAIT_L(0); PG8_MMA(0, 1, At, B1); PG8_BAR;
            PG8_LDA(At, 0, 1); PG8_STAGE(PG8_SA(0, 0), a2, voffA);
            PG8_BAR; PG8_WAIT_L(0); PG8_MMA(1, 0, At, B0); PG8_BAR; PG8_SCHED;
            PG8_STAGE(PG8_SB(0, 1), b2 + hstep, voffB);
            PG8_WAIT_V(6); PG8_BAR; PG8_MMA(1, 1, At, B1); PG8_BAR;
            PG8_LDB(B0, 1, 0); PG8_SCHED; PG8_LDA(At, 1, 0); PG8_STAGE(PG8_SA(0, 1), a2 + hstep, voffA);
            PG8_WAIT_L(8); PG8_BAR; PG8_WAIT_L(0); PG8_MMA(0, 0, At, B0); PG8_BAR; PG8_SCHED;
            PG8_LDB(B1, 1, 1); PG8_STAGE(PG8_SB(1, 0), b3, voffB);
            PG8_BAR; PG8_WAIT_L(0); PG8_MMA(0, 1, At, B1); PG8_BAR;
            PG8_LDA(At, 1, 1); PG8_STAGE(PG8_SA(1, 0), a3, voffA);
            PG8_BAR; PG8_WAIT_L(0); PG8_MMA(1, 0, At, B0); PG8_BAR; PG8_SCHED;
            PG8_STAGE(PG8_SB(1, 1), b3 + hstep, voffB);
            PG8_WAIT_V(6); PG8_BAR; PG8_MMA(1, 1, At, B1); PG8_BAR;
            }
        }
        if constexpr (ALIGN_EPI) { if (wr == 0) PG8_BAR; }
        if constexpr (!Epi::AFTER_DRAIN) { E(acc, cur, wr, wc, fr, fq); S.done(cur); }
        if (!has_next) break;
#pragma unroll
        for (int a = 0; a < 2; ++a)
#pragma unroll
            for (int b = 0; b < 2; ++b)
#pragma unroll
                for (int m = 0; m < 4; ++m)
#pragma unroll
                    for (int n = 0; n < 2; ++n) acc[a][b][m][n] = (f32x4){0.f, 0.f, 0.f, 0.f};
        cur = nxt; cA = nA; cB = nB; ++ui;
        if constexpr (ALIGN_EPI) { if (wr == 1) PG8_BAR; }
    }
    PG8_WAIT_V(0);
    if constexpr (!ALIGN_EPI) { if (wr == 0) PG8_BAR; }
    PG8_BAR;
    if constexpr (Epi::AFTER_DRAIN) { E.fused(acc, cur, wr, wc, fr, fq, lds, wid, lane); S.done(cur); }
#undef PG8_SA
#undef PG8_SB
#undef PG8_STAGE
#undef PG8_LDA
#undef PG8_LDB
#undef PG8_MMA
#undef PG8_WAIT_V
#undef PG8_WAIT_L
#undef PG8_BAR
#undef PG8_SCHED
}
}

#ifndef MK_MULTI_LAUNCH
#define MK_MULTI_LAUNCH 0
#endif
#define LAS __attribute__((address_space(3)))
typedef unsigned short bf16;
typedef float f32x4 __attribute__((ext_vector_type(4)));
typedef unsigned v4u __attribute__((ext_vector_type(4)));
typedef unsigned v2u __attribute__((ext_vector_type(2)));
typedef short bf16x8 __attribute__((ext_vector_type(8)));

constexpr int D = 1024, NP = 16384  , NS = 1024  , M = NP + NS, SEQ = 2048, DSEQ = 8, NBP = 8, NBS = 128, NB = NBP + NBS;
constexpr int FF = 2816, DC = 512, DP = 512, CW = 31, PM = 16, NMOD = 9, MODN = NMOD * D;
constexpr float EPS = 1e-6f;
constexpr size_t O_Y = 0, O_NSCP = (size_t)M * D, O_NSPP = O_NSCP + (size_t)NBP * 30 * DC, O_NSCS = O_NSPP + (size_t)NBP * 15 * DP, O_NSPS = O_NSCS + (size_t)NBS * 30 * DC;
constexpr size_t MiB = 1u << 20;
constexpr size_t WS_MOD = 1 * MiB;
constexpr size_t WS_WUP1 = 6 * MiB;
constexpr size_t WS_WDN1 = 17 * MiB;
constexpr size_t WS_WIN = 23 * MiB;
constexpr size_t WS_WOUT = 26 * MiB;
constexpr size_t WS_WUP2 = 28 * MiB;
constexpr size_t WS_WDN2 = 39 * MiB;
constexpr size_t WS_WADA = 45 * MiB;
constexpr size_t WS_SC = 63 * MiB;
constexpr size_t WS_A = 64 * MiB;
constexpr size_t WS_ACT = 98 * MiB;
constexpr size_t WS_END = 192 * MiB;
constexpr int LDS_BYTES = 147456;
constexpr int BAR_LDS_OFF = 131072 + 256;

__device__ __forceinline__ unsigned f2bf(float f) { unsigned u = __builtin_bit_cast(unsigned, f); return (u + 0x7fffu + ((u >> 16) & 1u)) >> 16; }
__device__ __forceinline__ unsigned pk2(float lo, float hi) { return f2bf(lo) | (f2bf(hi) << 16); }
__device__ __forceinline__ float bf2f(bf16 b) { return __builtin_bit_cast(float, (unsigned)b << 16); }
__device__ __forceinline__ float wave_sum(float v) {
#pragma unroll
    for (int o = 1; o < 64; o <<= 1) v += __shfl_xor(v, o);
    return v;
}
#define LDS_WAIT() asm volatile("s_waitcnt lgkmcnt(0)" ::: "memory")
#define XB_TMO      128
#define XB_XCNT(j)  (256  + 64 * (j))
#define XB_XSUB(j)  (1280 + 64 * (j))
#define XB_XGEN(j)  (2304 + 64 * (j))
#define XB_TOP      3328
#define XB_TOPGEN   3392
#define XCD_BAR_WORDS 3456
#define XB_SPIN_CAP (1u << 18)

__device__ __forceinline__ unsigned xb_ld(unsigned* p)              { return __hip_atomic_load(p, __ATOMIC_RELAXED, __HIP_MEMORY_SCOPE_AGENT); }
__device__ __forceinline__ unsigned xb_add(unsigned* p, unsigned v) { return __hip_atomic_fetch_add(p, v, __ATOMIC_RELAXED, __HIP_MEMORY_SCOPE_AGENT); }
__device__ __forceinline__ unsigned xb_xcc_id() { return (unsigned)__builtin_amdgcn_s_getreg((3 << 11) | 20) & 0xFu; }
#define XB_SPIN(cond, bar) do { unsigned _sp = 0; while (cond) { __builtin_amdgcn_s_sleep(1); \
    if ((++_sp & 255u) == 0u) { if (xb_ld(&(bar)[XB_TMO])) break; if (_sp > XB_SPIN_CAP) { atomicAdd(&(bar)[XB_TMO], 1u); break; } } } } while (0)

struct XcdBarrier {
    unsigned* bar; unsigned x;
    volatile LAS unsigned* st;
};

__device__ __forceinline__ XcdBarrier xcd_barrier_post(unsigned* bar, volatile LAS unsigned* st) {
    XcdBarrier b; b.bar = bar; b.x = xb_xcc_id(); b.st = st;
    if (threadIdx.x == 0) (void)xb_add(&bar[XB_XCNT(b.x)], 1u);
    return b;
}
__device__ __forceinline__ void xcd_barrier_complete(unsigned* bar, unsigned x, unsigned& nloc, unsigned& nx) {
    const unsigned G = gridDim.x * gridDim.y * gridDim.z;
    unsigned sum, cnt, mine, sp = 0u;
    for (;;) {
        sum = 0u; cnt = 0u; mine = 0u;
#pragma unroll
        for (unsigned j = 0; j < 16; ++j) { const unsigned c = xb_ld(&bar[XB_XCNT(j)]); sum += c; cnt += (c > 0u) ? 1u : 0u; mine = (j == x) ? c : mine; }
        if (sum == G) break;
        __builtin_amdgcn_s_sleep(1);
        if ((++sp & 255u) == 0u) { if (xb_ld(&bar[XB_TMO])) break; if (sp > XB_SPIN_CAP) { atomicAdd(&bar[XB_TMO], 1u); break; } }
    }
    nloc = mine > 0u ? mine : 1u; nx = cnt > 0u ? cnt : 1u;
}

__device__ __forceinline__ void xcd_barrier(const XcdBarrier& b) {
    asm volatile("s_waitcnt vmcnt(0)" ::: "memory");
    __syncthreads();
    if (threadIdx.x == 0) {
        unsigned* bar = b.bar;
        __builtin_amdgcn_s_waitcnt(0);
        unsigned nloc = b.st[0], nx = b.st[1];
        if (nloc == 0u) { xcd_barrier_complete(bar, b.x, nloc, nx); b.st[0] = nloc; b.st[1] = nx; }
        const unsigned old = xb_add(&bar[XB_XSUB(b.x)], 1u);
        const unsigned gen = old / nloc;
        if (old + 1u == (gen + 1u) * nloc) {
            __builtin_amdgcn_fence(__ATOMIC_RELEASE, "agent");
            asm volatile("s_waitcnt vmcnt(0)" ::: "memory");
            const unsigned og = xb_add(&bar[XB_TOP], 1u);
            const unsigned tg = og / nx;
            if (og + 1u == (tg + 1u) * nx) xb_add(&bar[XB_TOPGEN], 1u);
            else XB_SPIN(xb_ld(&bar[XB_TOPGEN]) == tg, bar);
            __builtin_amdgcn_fence(__ATOMIC_ACQUIRE, "agent");
            xb_add(&bar[XB_XGEN(b.x)], 1u);
            asm volatile("s_waitcnt vmcnt(0)" ::: "memory");
        } else {
            XB_SPIN(xb_ld(&bar[XB_XGEN(b.x)]) == gen, bar);
            __builtin_amdgcn_fence(__ATOMIC_ACQUIRE, "agent");
            asm volatile("s_waitcnt vmcnt(0)" ::: "memory");
        }
    }
    __syncthreads();
}

struct Args { const float* in[24]; float* out; unsigned char* ws; int ph_lo, ph_hi; };
enum { I_XP = 0, I_XS, I_SCONV, I_SPOOL, I_CP, I_CS, I_WADA, I_BADA, I_G1, I_WUP1, I_WDN1, I_GM, I_WIN, I_WDW, I_BDW, I_LNG, I_LNB, I_WPOOL, I_PSCALE, I_WOUT, I_G2, I_WUP2, I_WDN2, I_GF };

__device__ __forceinline__ void transpose_item(const float* W, int ldw, bf16* WT, int ldt, int k0, int n0, int drow0, LAS float* scr, int lane) {
#pragma unroll 8
    for (int i = 0; i < 32; ++i) { const int kk = 2 * i + (lane >> 5); scr[kk * 33 + (lane & 31)] = W[(size_t)(k0 + kk) * ldw + n0 + (lane & 31)]; }
    LDS_WAIT(); asm volatile("" ::: "memory");
    const int c = lane & 7;
#pragma unroll
    for (int j = 0; j < 4; ++j) { const int n = (lane >> 3) + 8 * j; const LAS float* s = scr + (8 * c) * 33 + n;
        v4u o; o.x = pk2(s[0 * 33], s[1 * 33]); o.y = pk2(s[2 * 33], s[3 * 33]); o.z = pk2(s[4 * 33], s[5 * 33]); o.w = pk2(s[6 * 33], s[7 * 33]);
        *(v4u*)(WT + (size_t)(drow0 + n) * ldt + k0 + 8 * c) = o; }
    LDS_WAIT(); asm volatile("" ::: "memory");
}
__device__ __forceinline__ int pair_row(int n, int half) { const int sec = n >= half ? 1 : 0, j = n - sec * half; return (j >> 7) * 256 + sec * 128 + (j & 127); }

__device__ __forceinline__ void p0_prologue(const Args& a, LAS unsigned char* lds, int G) {
    const int tid = threadIdx.x, lane = tid & 63, wave = __builtin_amdgcn_readfirstlane(tid >> 6);
    unsigned char* ws = a.ws;
    LAS float* scr = (LAS float*)(lds + wave * 16384);
    const int gw = blockIdx.x * 8 + wave, NGW = G * 8;
    constexpr int I_UP = (D / 64) * (2 * FF / 32), I_DN = (FF / 64) * (D / 32), I_IN = (D / 64) * (1536 / 32), I_OUT = (512 / 64) * (D / 32), I_ADA = (D / 64) * (MODN / 32);
    constexpr int NITEMS = 2 * I_UP + 2 * I_DN + I_IN + I_OUT + I_ADA;
    for (int it = gw; it < NITEMS; it += NGW) {
        int r = it;
        if (r < I_ADA) { const int nblk = MODN / 32, kb = r / nblk, nb = r % nblk; transpose_item(a.in[I_WADA], MODN, (bf16*)(ws + WS_WADA), D, kb * 64, nb * 32, nb * 32, scr, lane); continue; } r -= I_ADA;
        if (r < 2 * I_UP) { const int l = r >= I_UP; r -= l * I_UP; const int nblk = 2 * FF / 32, kb = r / nblk, nb = r % nblk;
            transpose_item(a.in[l ? I_WUP2 : I_WUP1], 2 * FF, (bf16*)(ws + (l ? WS_WUP2 : WS_WUP1)), D, kb * 64, nb * 32, pair_row(nb * 32, FF), scr, lane); continue; } r -= 2 * I_UP;
        if (r < 2 * I_DN) { const int l = r >= I_DN; r -= l * I_DN; const int nblk = D / 32, kb = r / nblk, nb = r % nblk;
            transpose_item(a.in[l ? I_WDN2 : I_WDN1], D, (bf16*)(ws + (l ? WS_WDN2 : WS_WDN1)), FF, kb * 64, nb * 32, nb * 32, scr, lane); continue; } r -= 2 * I_DN;
        if (r < I_IN) { const int nblk = 1536 / 32, kb = r / nblk, nb = r % nblk, n0 = nb * 32;
            transpose_item(a.in[I_WIN], 1536, (bf16*)(ws + WS_WIN), D, kb * 64, n0, n0 < 1024 ? pair_row(n0, 512) : n0, scr, lane); continue; } r -= I_IN;
        { const int nblk = D / 32, kb = r / nblk, nb = r % nblk; transpose_item(a.in[I_WOUT], D, (bf16*)(ws + WS_WOUT), D, kb * 64, nb * 32, nb * 32, scr, lane); }
    }
    const int gt = blockIdx.x * 512 + tid, NGT = G * 512;
    for (int i = gt; i < 144 * D / 4; i += NGT) { const int row = i / (D / 4), c4 = i % (D / 4);
        f32x4 v = (f32x4){0.f, 0.f, 0.f, 0.f};
        if (row < NBP) v = *(const f32x4*)(a.in[I_CP] + (size_t)row * D + c4 * 4); else if (row < NB) v = *(const f32x4*)(a.in[I_CS] + (size_t)(row - NBP) * D + c4 * 4);
        v2u o; o.x = pk2(v[0] * pg8::sigmoid_f(v[0]), v[1] * pg8::sigmoid_f(v[1])); o.y = pk2(v[2] * pg8::sigmoid_f(v[2]), v[3] * pg8::sigmoid_f(v[3]));
        *(v2u*)((bf16*)(ws + WS_SC) + (size_t)row * D + c4 * 4) = o; }
    for (int it = gt; it < 1024 * 64; it += NGT) { const int n = it & 1023, gc = it >> 10, g = gc >> 4, c8 = gc & 15;
        float acc[8];
#pragma unroll
        for (int i = 0; i < 8; ++i) acc[i] = 0.f;
        const float* wo = a.in[I_WOUT] + (size_t)(512 + 128 * g) * D + n; const float* ps = a.in[I_PSCALE] + 128 * g; const float* wp = a.in[I_WPOOL] + (size_t)(g * 128 + c8 * 8) * 128;
#pragma unroll 4
        for (int d = 0; d < 128; ++d) { const float w = wo[(size_t)d * D] * ps[d];
#pragma unroll
            for (int i = 0; i < 8; ++i) acc[i] = __builtin_fmaf(wp[i * 128 + d], w, acc[i]); }
        v4u o; o.x = pk2(acc[0], acc[1]); o.y = pk2(acc[2], acc[3]); o.z = pk2(acc[4], acc[5]); o.w = pk2(acc[6], acc[7]);
        *(v4u*)((bf16*)(ws + WS_WOUT) + (size_t)n * D + 512 + 128 * g + c8 * 8) = o; }
}

__device__ __forceinline__ void p1_mod(const Args& a, int G) {
    const int tid = threadIdx.x, lane = tid & 63, wave = __builtin_amdgcn_readfirstlane(tid >> 6), fr = lane & 15, fq = lane >> 4;
    const bf16* Wt = (const bf16*)(a.ws + WS_WADA); const bf16* SC = (const bf16*)(a.ws + WS_SC); float* mod = (float*)(a.ws + WS_MOD);
    const int gw = blockIdx.x * 8 + wave, NGW = G * 8;
    for (int item = gw; item < (MODN / 16) * 3; item += NGW) {
        const int nt = item / 3, bg = item % 3, n0 = nt * 16, b0 = bg * 48;
        f32x4 acc[3];
#pragma unroll
        for (int i = 0; i < 3; ++i) acc[i] = (f32x4){0.f, 0.f, 0.f, 0.f};
        const bf16* wp = Wt + (size_t)(n0 + fr) * D + fq * 8; const bf16* sp = SC + (size_t)(b0 + fr) * D + fq * 8;
#pragma unroll 4
        for (int ks = 0; ks < D / 32; ++ks) { const bf16x8 wf = *(const bf16x8*)(wp + ks * 32);
#pragma unroll
            for (int i = 0; i < 3; ++i) { const bf16x8 sf = *(const bf16x8*)(sp + (size_t)i * 16 * D + ks * 32); acc[i] = __builtin_amdgcn_mfma_f32_16x16x32_bf16(wf, sf, acc[i], 0, 0, 0); } }
        const int n = n0 + 4 * fq, slot = n >> 10, col = n & 1023, kind = slot % 3;
        const f32x4 bias = *(const f32x4*)(a.in[I_BADA] + n);
        f32x4 gv = (f32x4){1.f, 1.f, 1.f, 1.f};
        if (kind == 1) gv = *(const f32x4*)(a.in[slot == 1 ? I_G1 : (slot == 4 ? I_GM : I_G2)] + col);
        const float gs = (slot == 2 || slot == 8) ? 0.5f : 1.0f;
#pragma unroll
        for (int i = 0; i < 3; ++i) { const int b = b0 + 16 * i + fr; f32x4 v = acc[i] + bias;
            if (kind == 1) v = gv * (v + 1.0f); else if (kind == 2) v = v * gs;
            if (b < NB) *(f32x4*)(mod + (size_t)b * MODN + n) = v; }
    }
}

template <bool FROM_X> __device__ __forceinline__ void norm_phase(const Args& a, int G, int slot_shift) {
    const int tid = threadIdx.x, lane = tid & 63, wave = __builtin_amdgcn_readfirstlane(tid >> 6);
    const float* mod = (const float*)(a.ws + WS_MOD); bf16* A = (bf16*)(a.ws + WS_A);
    const int gw = blockIdx.x * 8 + wave, NGW = G * 8;
    for (int row = gw; row < M; row += NGW) {
        const float* src = FROM_X ? (row < NP ? a.in[I_XP] + (size_t)row * D : a.in[I_XS] + (size_t)(row - NP) * D) : a.out + (size_t)row * D;
        const f32x4* xr = (const f32x4*)src + lane;
        f32x4 v[4]; float s = 0.f;
#pragma unroll
        for (int j = 0; j < 4; ++j) { v[j] = xr[64 * j]; s += (v[j].x * v[j].x + v[j].y * v[j].y) + (v[j].z * v[j].z + v[j].w * v[j].w); }
        const float r = 1.0f / sqrtf(wave_sum(s) * (1.0f / D) + EPS);
        const float* mrow = mod + (size_t)pg8::mod_row(row) * MODN + (size_t)slot_shift * D;
        const f32x4* sh = (const f32x4*)mrow + lane; const f32x4* cs = (const f32x4*)(mrow + D) + lane;
        v2u* o8 = (v2u*)(A + (size_t)row * D) + lane;
#pragma unroll
        for (int j = 0; j < 4; ++j) { const f32x4 c = cs[64 * j], h = sh[64 * j]; const f32x4 y = v[j] * r * c + h; v2u o; o.x = pk2(y.x, y.y); o.y = pk2(y.z, y.w); o8[64 * j] = o; }
    }
}
__device__ __forceinline__ void final_norm_phase(const Args& a, int G) {
    const int tid = threadIdx.x, lane = tid & 63, wave = __builtin_amdgcn_readfirstlane(tid >> 6);
    const int gw = blockIdx.x * 8 + wave, NGW = G * 8;
    const f32x4* gf = (const f32x4*)a.in[I_GF] + lane;
    for (int row = gw; row < M; row += NGW) {
        f32x4* xr = (f32x4*)(a.out + (size_t)row * D) + lane;
        f32x4 v[4]; float s = 0.f;
#pragma unroll
        for (int j = 0; j < 4; ++j) { v[j] = xr[64 * j]; s += (v[j].x * v[j].x + v[j].y * v[j].y) + (v[j].z * v[j].z + v[j].w * v[j].w); }
        const float r = 1.0f / sqrtf(wave_sum(s) * (1.0f / D) + EPS);
#pragma unroll
        for (int j = 0; j < 4; ++j) xr[64 * j] = v[j] * r * gf[64 * j];
    }
}

__device__ __forceinline__ void mixer_phase(const Args& a, LAS unsigned char* lds, int G) {
    const int tid = threadIdx.x, lane = tid & 63, wave = __builtin_amdgcn_readfirstlane(tid >> 6), c = tid;
    const bf16* U = (const bf16*)(a.ws + WS_ACT); bf16* A = (bf16*)(a.ws + WS_A);
    LAS float* vbuf = (LAS float*)lds;
    float wdw[CW];
#pragma unroll
    for (int k = 0; k < CW; ++k) wdw[k] = a.in[I_WDW][k * DC + c];
    const float bdw = a.in[I_BDW][c];
    const int gi = c >> 7, win = 2 << gi;
    for (int uidx = blockIdx.x; uidx < M / 8; uidx += G) {
        const bool prompt = uidx < NP / 8;
        const int b = prompt ? uidx / (SEQ / 8) : uidx - NP / 8, t0 = prompt ? (uidx % (SEQ / 8)) * 8 : 0, row0 = prompt ? b * SEQ + t0 : NP + b * 8;
        float in[38];
        if (prompt) {
#pragma unroll
            for (int i = 0; i < 38; ++i) in[i] = (t0 - 30 + i >= 0) ? bf2f(U[(size_t)(row0 - 30 + i) * D + c]) : 0.f;
        } else {
            const float* st = a.in[I_SCONV] + (size_t)b * 30 * DC + c;
#pragma unroll
            for (int i = 0; i < 30; ++i) in[i] = st[i * DC];
#pragma unroll
            for (int i = 30; i < 38; ++i) in[i] = bf2f(U[(size_t)(row0 + i - 30) * D + c]);
        }
#pragma unroll
        for (int tt = 0; tt < 8; ++tt) { float s = bdw;
#pragma unroll
            for (int k = 0; k < CW; ++k) s = __builtin_fmaf(wdw[k], in[tt + k], s);
            vbuf[tt * DC + c] = s; }
        if (prompt) { if (t0 + 8 > SEQ - 30) {
#pragma unroll
                for (int tt = 0; tt < 8; ++tt) if (t0 + tt >= SEQ - 30) a.out[O_NSCP + (size_t)(b * 30 + t0 + tt - (SEQ - 30)) * DC + c] = in[30 + tt]; }
        } else { float* o = a.out + O_NSCS + (size_t)b * 30 * DC + c;
#pragma unroll
            for (int e = 8; e < 38; ++e) o[(e - 8) * DC] = in[e]; }
        float pin[23];
        if (prompt) {
#pragma unroll
            for (int i = 0; i < 23; ++i) pin[i] = (t0 - 15 + i >= 0) ? bf2f(U[(size_t)(row0 - 15 + i) * D + DC + c]) : 0.f;
        } else {
            const float* st = a.in[I_SPOOL] + (size_t)b * 15 * DP + c;
#pragma unroll
            for (int i = 0; i < 15; ++i) pin[i] = st[i * DP];
#pragma unroll
            for (int i = 15; i < 23; ++i) pin[i] = bf2f(U[(size_t)(row0 + i - 15) * D + DC + c]);
        }
#pragma unroll
        for (int tt = 0; tt < 8; ++tt) { const float cur = pin[15 + tt];
            const float s2 = cur + pin[14 + tt], s4 = s2 + (pin[13 + tt] + pin[12 + tt]), s8 = s4 + ((pin[11 + tt] + pin[10 + tt]) + (pin[9 + tt] + pin[8 + tt]));
            const float s16 = s8 + (((pin[7 + tt] + pin[6 + tt]) + (pin[5 + tt] + pin[4 + tt])) + ((pin[3 + tt] + pin[2 + tt]) + (pin[1 + tt] + pin[0 + tt])));
            const float s = gi == 0 ? s2 : (gi == 1 ? s4 : (gi == 2 ? s8 : s16));
            const int cnt = prompt ? (t0 + tt + 1 < win ? t0 + tt + 1 : win) : win;
            A[(size_t)(row0 + tt) * D + DC + c] = (bf16)f2bf(s / (float)cnt - cur); }
        if (prompt) { if (t0 + 8 > SEQ - 15) {
#pragma unroll
                for (int tt = 0; tt < 8; ++tt) if (t0 + tt >= SEQ - 15) a.out[O_NSPP + (size_t)(b * 15 + t0 + tt - (SEQ - 15)) * DP + c] = pin[15 + tt]; }
        } else { float* o = a.out + O_NSPS + (size_t)b * 15 * DP + c;
#pragma unroll
            for (int e = 8; e < 23; ++e) o[(e - 8) * DP] = pin[e]; }
        LDS_WAIT(); __syncthreads();
        { const LAS float* vr = vbuf + wave * DC + lane * 8; const f32x4 x0 = *(const LAS f32x4*)vr, x1 = *(const LAS f32x4*)(vr + 4);
            const float mean = wave_sum((x0.x + x0.y) + (x0.z + x0.w) + (x1.x + x1.y) + (x1.z + x1.w)) * (1.0f / DC);
            const f32x4 d0 = x0 - mean, d1 = x1 - mean;
            const float var = wave_sum((d0.x * d0.x + d0.y * d0.y) + (d0.z * d0.z + d0.w * d0.w) + (d1.x * d1.x + d1.y * d1.y) + (d1.z * d1.z + d1.w * d1.w)) * (1.0f / DC);
            const float rstd = 1.0f / sqrtf(var + EPS);
            const f32x4 g0 = *(const f32x4*)(a.in[I_LNG] + lane * 8), g1 = *(const f32x4*)(a.in[I_LNG] + lane * 8 + 4), b0 = *(const f32x4*)(a.in[I_LNB] + lane * 8), b1 = *(const f32x4*)(a.in[I_LNB] + lane * 8 + 4);
            f32x4 y0 = d0 * rstd * g0 + b0, y1 = d1 * rstd * g1 + b1;
#pragma unroll
            for (int j = 0; j < 4; ++j) { y0[j] = y0[j] * pg8::sigmoid_f(y0[j]); y1[j] = y1[j] * pg8::sigmoid_f(y1[j]); }
            v4u o; o.x = pk2(y0.x, y0.y); o.y = pk2(y0.z, y0.w); o.z = pk2(y1.x, y1.y); o.w = pk2(y1.z, y1.w);
            *(v4u*)(A + (size_t)(row0 + wave) * D + lane * 8) = o; }
        LDS_WAIT(); __syncthreads();
    }
}

constexpr int N_PHASES = 13;
__global__ void __launch_bounds__(512, 2) fwd_megakernel(Args args) {
    extern __shared__ __attribute__((aligned(16))) unsigned char lds_raw[];
    LAS unsigned char* lds = (LAS unsigned char*)lds_raw;
    const int G = gridDim.x, lo = args.ph_lo, hi = args.ph_hi;
    unsigned char* ws = args.ws;
    float* mod = (float*)(ws + WS_MOD);
    bf16* Abuf = (bf16*)(ws + WS_A); bf16* ACT = (bf16*)(ws + WS_ACT);
#define IN(k) (lo <= (k) && (k) < hi)
    volatile LAS unsigned* bst = (volatile LAS unsigned*)(lds + BAR_LDS_OFF);
    if (threadIdx.x < 4) bst[threadIdx.x] = 0u;
    __syncthreads();
    XcdBarrier bar; bar.bar = (unsigned*)ws; bar.x = 0; bar.st = nullptr;
    if (!MK_MULTI_LAUNCH) bar = xcd_barrier_post((unsigned*)ws, bst);
    if (hi > N_PHASES) cg::this_grid().sync();
#if MK_MULTI_LAUNCH
#define SEAM(k) do { } while (0)
#else
#define SEAM(k) do { if (IN(k) && IN((k) + 1)) xcd_barrier(bar); } while (0)
#endif
    if (IN(0)) { p0_prologue(args, lds, G); } SEAM(0);
    if (IN(1)) { p1_mod(args, G); } SEAM(1);
    if (IN(2)) { norm_phase<true>(args, G, 0); } SEAM(2);
    if (IN(3)) { pg8::Gemm g{Abuf, (const bf16*)(ws + WS_WUP1), M, 2 * FF, D}; pg8::StaticOrder S; S.init(M, 2 * FF, G, (int)blockIdx.x);
        pg8::EpiGate<0> E{ACT, FF}; pg8::gemm_phase<pg8::EpiGate<0>, pg8::StaticOrder, true, true>(lds, g, S, E); } SEAM(3);
    if (IN(4)) { pg8::Gemm g{ACT, (const bf16*)(ws + WS_WDN1), M, D, FF}; pg8::StaticOrder S; S.init(M, D, G, (int)blockIdx.x);
        pg8::EpiResid<true> E{args.in[I_XP], args.in[I_XS], args.out, mod + 2 * D}; pg8::gemm_phase<pg8::EpiResid<true>, pg8::StaticOrder, true, true>(lds, g, S, E); } SEAM(4);
    if (IN(5)) { norm_phase<false>(args, G, 3); } SEAM(5);
    if (IN(6)) { pg8::Gemm g{Abuf, (const bf16*)(ws + WS_WIN), M, 1536, D}; pg8::StaticOrder S; S.init(M, 1536, G, (int)blockIdx.x);
        pg8::EpiGate<1> E{ACT, D}; pg8::gemm_phase<pg8::EpiGate<1>, pg8::StaticOrder, true, true>(lds, g, S, E); } SEAM(6);
    if (IN(7)) { mixer_phase(args, lds, G); } SEAM(7);
    if (IN(8)) { pg8::Gemm g{Abuf, (const bf16*)(ws + WS_WOUT), M, D, D}; pg8::StaticOrder S; S.init(M, D, G, (int)blockIdx.x);
        pg8::EpiResid<false> E{nullptr, nullptr, args.out, mod + 5 * D}; pg8::gemm_phase<pg8::EpiResid<false>, pg8::StaticOrder, true, true>(lds, g, S, E); } SEAM(8);
    if (IN(9)) { norm_phase<false>(args, G, 6); } SEAM(9);
    if (IN(10)) { pg8::Gemm g{Abuf, (const bf16*)(ws + WS_WUP2), M, 2 * FF, D}; pg8::StaticOrder S; S.init(M, 2 * FF, G, (int)blockIdx.x);
        pg8::EpiGate<0> E{ACT, FF}; pg8::gemm_phase<pg8::EpiGate<0>, pg8::StaticOrder, true, true>(lds, g, S, E); } SEAM(10);
    if (IN(11)) { pg8::Gemm g{ACT, (const bf16*)(ws + WS_WDN2), M, D, FF}; pg8::StaticOrder S; S.init(M, D, G, (int)blockIdx.x);
        pg8::EpiResid<false> E{nullptr, nullptr, args.out, mod + 8 * D}; pg8::gemm_phase<pg8::EpiResid<false>, pg8::StaticOrder, true, true>(lds, g, S, E); } SEAM(11);
    if (IN(12)) { final_norm_phase(args, G); }
#undef IN
#undef SEAM
}

extern "C" void kernel_launch(void* const* d_in, const int* in_sizes, int n_in, void* d_out, int out_size, void* d_ws, size_t ws_size, hipStream_t stream) {
    static int grid = 0;
    if (grid == 0) {
        if (n_in != 24 || ws_size < WS_END) { fprintf(stderr, "kernel_launch: unexpected n_in %d / ws %zu\n", n_in, ws_size); grid = -1; return; }
        int dev = 0, cus = 0, per_cu = 0;
        (void)hipGetDevice(&dev); (void)hipDeviceGetAttribute(&cus, hipDeviceAttributeMultiprocessorCount, dev);
        if (hipFuncSetAttribute((const void*)fwd_megakernel, hipFuncAttributeMaxDynamicSharedMemorySize, LDS_BYTES) != hipSuccess) { fprintf(stderr, "kernel_launch: hipFuncSetAttribute failed\n"); grid = -1; return; }
        if (hipOccupancyMaxActiveBlocksPerMultiprocessor(&per_cu, (const void*)fwd_megakernel, 512, LDS_BYTES) != hipSuccess || per_cu < 1) { fprintf(stderr, "kernel_launch: occupancy query says %d blocks/CU\n", per_cu); per_cu = 1; (void)hipGetLastError(); }
        grid = cus;
        if (grid <= 0) grid = 256;
    }
    if (grid < 0) return;
    Args a{};
    for (int i = 0; i < 24; ++i) a.in[i] = (const float*)d_in[i];
    a.out = (float*)d_out; a.ws = (unsigned char*)d_ws;
#if MK_MULTI_LAUNCH
    for (int ph = 0; ph < N_PHASES; ++ph) { a.ph_lo = ph; a.ph_hi = ph + 1; hipLaunchKernelGGL(fwd_megakernel, dim3(grid), dim3(512), LDS_BYTES, stream, a); }
#else
    a.ph_lo = 0; a.ph_hi = N_PHASES;
    if (hipMemsetAsync(d_ws, 0, 16384, stream) != hipSuccess) { fprintf(stderr, "kernel_launch: memset of the barrier words failed\n"); return; }
    void* kargs[] = {&a};
    hipError_t e = hipLaunchCooperativeKernel((const void*)fwd_megakernel, dim3(grid), dim3(512), kargs, LDS_BYTES, stream);
    if (e != hipSuccess) fprintf(stderr, "kernel_launch: cooperative launch failed: %s (grid %d)\n", hipGetErrorString(e), grid);
#endif
}
```

```cpp
#include <hip/hip_runtime.h>
#include <hip/hip_cooperative_groups.h>
#include <cstdio>
#include <cstdint>
namespace cg = cooperative_groups;
#define MK_MULTI_LAUNCH 0
namespace pg8 {
#define PG8_LAS __attribute__((address_space(3)))
typedef unsigned short bf16_t;
typedef short bf16x8 __attribute__((ext_vector_type(8)));
typedef float f32x4 __attribute__((ext_vector_type(4)));
typedef unsigned u32x4 __attribute__((ext_vector_type(4)));
constexpr int BM = 256, BK = 64, HALF = 128, HTB = HALF * BK * 2  , STAGE_BYTES = 8 * HTB, NXCD = 8, WGM = 8;

__host__ __device__ __forceinline__ int lds_byte(int r, int c) { const int st = (r >> 4) * 2 + (c >> 5), rr = r & 15, cc = c & 31, ob = rr * 64 + cc * 2; return st * 1024 + (ob ^ (((ob >> 9) & 1) << 5)); }
__host__ __device__ __forceinline__ void stage_rc(int b, int& R, int& C) { const int st = b / 1024, sb = b % 1024, swz = sb ^ (((sb >> 9) & 1) << 5); R = (st >> 1) * 16 + swz / 64; C = (st & 1) * 32 + (swz % 64) / 2; }
__host__ __device__ __forceinline__ int perm32(int rho) { const int n = rho >> 4, i = rho & 15; return 8 * (i >> 2) + 4 * n + (i & 3); }

struct Unit { int pm, pn; };
struct Gemm { const bf16_t* A; const bf16_t* Bt; int M, N, K; };

struct StaticOrder {
    int nM, nN, nwg, G, c;
    __host__ __device__ void init(int M, int N, int G_, int c_) { nM = M / BM; nN = N / BM; nwg = nM * nN; G = G_; c = c_; }
    __host__ __device__ bool next(int i, Unit& u) const {
        const long L = (long)i * G + c; if (L >= nwg) return false;
        int wgid = (int)L; { const int q = nwg / NXCD, r = nwg % NXCD, xcd = wgid % NXCD, off = wgid / NXCD; wgid = (xcd < r ? xcd * (q + 1) : r * (q + 1) + (xcd - r) * q) + off; }
        const int nig = WGM * nN, gid = wgid / nig, fm = gid * WGM, gsz = (nM - fm) < WGM ? (nM - fm) : WGM;
        u.pm = fm + ((wgid % nig) % gsz); u.pn = (wgid % nig) / gsz; return true;
    }
    __device__ __forceinline__ void a_ready(const Unit&) const {}
    __device__ __forceinline__ void done(const Unit&) const {}
};

__device__ __forceinline__ unsigned cvt_pk_bf16(float lo, float hi) { unsigned r; asm volatile("v_cvt_pk_bf16_f32 %0, %1, %2" : "=v"(r) : "v"(lo), "v"(hi)); return r; }
typedef float f32x2 __attribute__((ext_vector_type(2)));
constexpr int NROW_PROMPT = 16384, MODLD = 9216, DM = 1024;
__device__ __forceinline__ int mod_row(int r) { return r < NROW_PROMPT ? (r >> 11) : 8 + ((r - NROW_PROMPT) >> 3); }
__device__ __forceinline__ float sigmoid_f(float g) { return __builtin_amdgcn_rcpf(1.0f + __builtin_amdgcn_exp2f(-1.44269504089f * g)); }

template <int MODE> struct EpiGate {
    static constexpr bool PERM = true, AFTER_DRAIN = false;
    bf16_t* O; int ldc;
    __device__ __forceinline__ void operator()(const f32x4 (&acc)[2][2][4][2], const Unit& u, int wr, int wc, int fr, int fq) const {
        const int row0 = u.pm * BM + wr * 64 + fr;
        if (MODE == 0 || u.pn < 4) {
            const int col0 = u.pn * 128 + wc * 32 + 8 * fq;
#pragma unroll
            for (int ai = 0; ai < 2; ++ai)
#pragma unroll
                for (int m = 0; m < 4; ++m) { bf16_t* rowp = O + (size_t)(row0 + ai * HALF + m * 16) * ldc + col0;
                    float o[8];
#pragma unroll
                    for (int n = 0; n < 2; ++n)
#pragma unroll
                        for (int j = 0; j < 4; ++j) { const float a = acc[ai][0][m][n][j], b = acc[ai][1][m][n][j];
                            o[n * 4 + j] = (MODE == 0) ? a * sigmoid_f(a) * b : a * sigmoid_f(b); }
                    u32x4 w; w.x = cvt_pk_bf16(o[0], o[1]); w.y = cvt_pk_bf16(o[2], o[3]); w.z = cvt_pk_bf16(o[4], o[5]); w.w = cvt_pk_bf16(o[6], o[7]);
                    *(u32x4*)rowp = w; }
        } else {
            const int col0 = 512 + (u.pn - 4) * 256 + wc * 32 + 8 * fq;
#pragma unroll
            for (int ai = 0; ai < 2; ++ai)
#pragma unroll
                for (int m = 0; m < 4; ++m) { bf16_t* rowp = O + (size_t)(row0 + ai * HALF + m * 16) * ldc + col0;
#pragma unroll
                    for (int bj = 0; bj < 2; ++bj) { const f32x4 v0 = acc[ai][bj][m][0], v1 = acc[ai][bj][m][1];
                        u32x4 w; w.x = cvt_pk_bf16(v0[0], v0[1]); w.y = cvt_pk_bf16(v0[2], v0[3]); w.z = cvt_pk_bf16(v1[0], v1[1]); w.w = cvt_pk_bf16(v1[2], v1[3]);
                        *(u32x4*)(rowp + bj * HALF) = w; } }
        }
    }
};
template <bool FROM_X> struct EpiResid {
    static constexpr bool PERM = false, AFTER_DRAIN = false;
    const float* xp; const float* xs; float* h; const float* gate;
    __device__ __forceinline__ void operator()(const f32x4 (&acc)[2][2][4][2], const Unit& u, int wr, int wc, int fr, int fq) const {
        const int col0 = u.pn * BM + wc * 32 + 4 * fq;
#pragma unroll
        for (int ai = 0; ai < 2; ++ai)
#pragma unroll
            for (int m = 0; m < 4; ++m) { const int row = u.pm * BM + ai * HALF + wr * 64 + m * 16 + fr;
                const float* gt = gate + (size_t)mod_row(row) * MODLD + col0;
                const float* base = (FROM_X ? (row < NROW_PROMPT ? xp + (size_t)row * DM : xs + (size_t)(row - NROW_PROMPT) * DM) : h + (size_t)row * DM) + col0;
                float* o = h + (size_t)row * DM + col0;
#pragma unroll
                for (int bj = 0; bj < 2; ++bj)
#pragma unroll
                    for (int n = 0; n < 2; ++n) { const int off = bj * HALF + n * 16; const f32x4 b = *(const f32x4*)(base + off), g = *(const f32x4*)(gt + off);
                        *(f32x4*)(o + off) = b + g * acc[ai][bj][m][n]; }
                asm volatile("" ::: "memory"); }
    }
};
template <class Epi, class Sched, bool ALIGN_EPI = false, bool SP2 = false>
__device__ __forceinline__ void gemm_phase(PG8_LAS unsigned char* lds, const Gemm g, const Sched& S, const Epi& E) {
    const int tid = threadIdx.x, wid = __builtin_amdgcn_readfirstlane(tid >> 6), lane = tid & 63, wr = wid >> 2, wc = wid & 3, fr = lane & 15, fq = lane >> 4;
    const int K = g.K, nt = K / BK;
    unsigned voffA[2], voffB[2];
#pragma unroll
    for (int i = 0; i < 2; ++i) { int R, C; stage_rc(tid * 16 + i * 8192, R, C); const int Rb = Epi::PERM ? ((R & ~31) + perm32(R & 31)) : R;
        voffA[i] = (unsigned)(R * K + C) * 2u; voffB[i] = (unsigned)(Rb * K + C) * 2u; }
    const size_t kstep = (size_t)(BK * 2);
    const size_t hstep = (size_t)HALF * K * 2;
    const size_t tstep = 2 * hstep;
    const unsigned ldsw = (unsigned)wid * 1024u;
    const int aoff = lds_byte(wr * 64 + fr, fq * 8), boff = lds_byte(wc * 32 + fr, fq * 8);
#define PG8_SA(b, h) (((b) * 2 + (h)) * HTB)
#define PG8_SB(b, h) ((4 + (b) * 2 + (h)) * HTB)
#define PG8_STAGE(bufoff, gbase, voff) do { _Pragma("unroll") for (int _i = 0; _i < 2; ++_i) \
        __builtin_amdgcn_global_load_lds((const unsigned*)((const char*)(gbase) + (voff)[_i]), (PG8_LAS unsigned*)(lds + (bufoff) + ldsw + _i * 8192), 16, 0, 0); } while (0)
#define PG8_LDA(dst, b, h) do { _Pragma("unroll") for (int m = 0; m < 4; ++m) _Pragma("unroll") for (int k = 0; k < 2; ++k) dst[m][k] = *(const PG8_LAS bf16x8*)(lds + PG8_SA(b, h) + aoff + m * 2048 + k * 1024); } while (0)
#define PG8_LDB(dst, b, h) do { _Pragma("unroll") for (int n = 0; n < 2; ++n) _Pragma("unroll") for (int k = 0; k < 2; ++k) dst[n][k] = *(const PG8_LAS bf16x8*)(lds + PG8_SB(b, h) + boff + n * 2048 + k * 1024); } while (0)
#define PG8_MMA(ai, bj, At, Bt) do { __builtin_amdgcn_s_setprio(1); _Pragma("unroll") for (int m = 0; m < 4; ++m) _Pragma("unroll") for (int n = 0; n < 2; ++n) _Pragma("unroll") for (int k = 0; k < 2; ++k) \
        acc[ai][bj][m][n] = __builtin_amdgcn_mfma_f32_16x16x32_bf16(Bt[n][k], At[m][k], acc[ai][bj][m][n], 0, 0, 0); __builtin_amdgcn_s_setprio(0); } while (0)
#define PG8_WAIT_V(n) asm volatile("s_waitcnt vmcnt(" #n ")" ::: "memory")
#define PG8_WAIT_L(n) asm volatile("s_waitcnt lgkmcnt(" #n ")" ::: "memory")
#define PG8_BAR __builtin_amdgcn_s_barrier()
#define PG8_SCHED __builtin_amdgcn_sched_barrier(0)
    Unit cur, nxt; int ui = 0;
    if (!S.next(0, cur)) return;
    f32x4 acc[2][2][4][2];
#pragma unroll
    for (int a = 0; a < 2; ++a)
#pragma unroll
        for (int b = 0; b < 2; ++b)
#pragma unroll
            for (int m = 0; m < 4; ++m)
#pragma unroll
                for (int n = 0; n < 2; ++n) acc[a][b][m][n] = (f32x4){0.f, 0.f, 0.f, 0.f};
    bf16x8 At[4][2], B0[2][2], B1[2][2];
    const char* cA = (const char*)g.A + (size_t)cur.pm * tstep; const char* cB = (const char*)g.Bt + (size_t)cur.pn * tstep;
    S.a_ready(cur);
    if constexpr (SP2) {
        PG8_STAGE(PG8_SB(0, 0), cB, voffB); PG8_STAGE(PG8_SB(0, 1), cB + hstep, voffB); PG8_STAGE(PG8_SA(0, 0), cA, voffA); PG8_STAGE(PG8_SA(0, 1), cA + hstep, voffA);
        if (wr == 1) PG8_BAR;
        PG8_WAIT_V(2); PG8_BAR;
        PG8_STAGE(PG8_SB(1, 0), cB + kstep, voffB); PG8_STAGE(PG8_SA(1, 0), cA + kstep, voffA); PG8_STAGE(PG8_SB(1, 1), cB + hstep + kstep, voffB);
        PG8_WAIT_V(6); PG8_BAR;
    } else {
        PG8_STAGE(PG8_SB(0, 0), cB, voffB); PG8_STAGE(PG8_SA(0, 0), cA, voffA); PG8_STAGE(PG8_SB(0, 1), cB + hstep, voffB); PG8_STAGE(PG8_SA(0, 1), cA + hstep, voffA);
        if (wr == 1) PG8_BAR;
        PG8_WAIT_V(4); PG8_BAR;
        PG8_STAGE(PG8_SB(1, 0), cB + kstep, voffB); PG8_STAGE(PG8_SA(1, 0), cA + kstep, voffA); PG8_STAGE(PG8_SB(1, 1), cB + hstep + kstep, voffB);
        PG8_WAIT_V(6); PG8_BAR;
    }
    for (;;) {
        const bool has_next = S.next(ui + 1, nxt);
        const char* nA = has_next ? (const char*)g.A + (size_t)nxt.pm * tstep : cA; const char* nB = has_next ? (const char*)g.Bt + (size_t)nxt.pn * tstep : cB;
        for (int t = 0; t < nt; t += 2) {
            const bool last = (t == nt - 2);
            const char* a1 = cA + (size_t)(t + 1) * kstep;
            const char* a2 = last ? nA : cA + (size_t)(t + 2) * kstep; const char* b2 = last ? nB : cB + (size_t)(t + 2) * kstep;
            const char* a3 = a2 + kstep; const char* b3 = b2 + kstep;
            if (last && has_next) S.a_ready(nxt);
            if constexpr (SP2) {
            PG8_LDB(B0, 0, 0); PG8_LDB(B1, 0, 1); PG8_SCHED; PG8_LDA(At, 0, 0); PG8_STAGE(PG8_SA(1, 1), a1 + hstep, voffA);
            PG8_WAIT_V(8); PG8_WAIT_L(0); PG8_BAR; PG8_MMA(0, 0, At, B0); PG8_MMA(0, 1, At, B1); PG8_BAR; PG8_SCHED;
            PG8_LDA(At, 0, 1); PG8_STAGE(PG8_SB(0, 0), b2, voffB); PG8_STAGE(PG8_SB(0, 1), b2 + hstep, voffB); PG8_STAGE(PG8_SA(0, 0), a2, voffA);
            PG8_WAIT_V(8); PG8_WAIT_L(0); PG8_BAR; PG8_MMA(1, 0, At, B0); PG8_MMA(1, 1, At, B1); PG8_BAR; PG8_SCHED;
            PG8_LDB(B0, 1, 0); PG8_LDB(B1, 1, 1); PG8_SCHED; PG8_LDA(At, 1, 0); PG8_STAGE(PG8_SA(0, 1), a2 + hstep, voffA);
            PG8_WAIT_V(8); PG8_WAIT_L(0); PG8_BAR; PG8_MMA(0, 0, At, B0); PG8_MMA(0, 1, At, B1); PG8_BAR; PG8_SCHED;
            PG8_LDA(At, 1, 1); PG8_STAGE(PG8_SB(1, 0), b3, voffB); PG8_STAGE(PG8_SB(1, 1), b3 + hstep, voffB); PG8_STAGE(PG8_SA(1, 0), a3, voffA);
            PG8_WAIT_V(8); PG8_WAIT_L(0); PG8_BAR; PG8_MMA(1, 0, At, B0); PG8_MMA(1, 1, At, B1); PG8_BAR; PG8_SCHED;
            } else {
            PG8_LDB(B0, 0, 0); PG8_SCHED; PG8_LDA(At, 0, 0); PG8_STAGE(PG8_SA(1, 1), a1 + hstep, voffA);
            PG8_WAIT_L(8); PG8_BAR; PG8_WAIT_L(0); PG8_MMA(0, 0, At, B0); PG8_BAR; PG8_SCHED;
            PG8_LDB(B1, 0, 1); PG8_STAGE(PG8_SB(0, 0), b2, voffB);
            PG8_BAR; PG8_WAIT_L(0); PG8_MMA(0, 1, At, B1); PG8_BAR;
            PG8_LDA(At, 0, 1); PG8_STAGE(PG8_SA(0, 0), a2, voffA);
            PG8_BAR; PG8_WAIT_L(0); PG8_MMA(1, 0, At, B0); PG8_BAR; PG8_SCHED;
            PG8_STAGE(PG8_SB(0, 1), b2 + hstep, voffB);
            PG8_WAIT_V(6); PG8_BAR; PG8_MMA(1, 1, At, B1); PG8_BAR;
            PG8_LDB(B0, 1, 0); PG8_SCHED; PG8_LDA(At, 1, 0); PG8_STAGE(PG8_SA(0, 1), a2 + hstep, voffA);
            PG8_WAIT_L(8); PG8_BAR; PG8_WAIT_L(0); PG8_MMA(0, 0, At, B0); PG8_BAR; PG8_SCHED;
            PG8_LDB(B1, 1, 1); PG8_STAGE(PG8_SB(1, 0), b3, voffB);
            PG8_BAR; PG8_WAIT_L(0); PG8_MMA(0, 1, At, B1); PG8_BAR;
            PG8_LDA(At, 1, 1); PG8_STAGE(PG8_SA(1, 0), a3, voffA);
            PG8_BAR; PG8_WAIT_L(0); PG8_MMA(1, 0, At, B0); PG8_BAR; PG8_SCHED;
            PG8_STAGE(PG8_SB(1, 1), b3 + hstep, voffB);
            PG8_WAIT_V(6); PG8_BAR; PG8_MMA(1, 1, At, B1); PG8_BAR;
            }
        }
        if constexpr (ALIGN_EPI) { if (wr == 0) PG8_BAR; }
        if constexpr (!Epi::AFTER_DRAIN) { E(acc, cur, wr, wc, fr, fq); S.done(cur); }
        if (!has_next) break;
#pragma unroll
        for (int a = 0; a < 2; ++a)
#pragma unroll
            for (int b = 0; b < 2; ++b)
#pragma unroll
                for (int m = 0; m < 4; ++m)
#pragma unroll
                    for (int n = 0; n < 2; ++n) acc[a][b][m][n] = (f32x4){0.f, 0.f, 0.f, 0.f};
        cur = nxt; cA = nA; cB = nB; ++ui;
        if constexpr (ALIGN_EPI) { if (wr == 1) PG8_BAR; }
    }
    PG8_WAIT_V(0);
    if constexpr (!ALIGN_EPI) { if (wr == 0) PG8_BAR; }
    PG8_BAR;
    if constexpr (Epi::AFTER_DRAIN) { E.fused(acc, cur, wr, wc, fr, fq, lds, wid, lane); S.done(cur); }
#undef PG8_SA
#undef PG8_SB
#undef PG8_STAGE
#undef PG8_LDA
#undef PG8_LDB
#undef PG8_MMA
#undef PG8_WAIT_V
#undef PG8_WAIT_L
#undef PG8_BAR
#undef PG8_SCHED
}
}

#ifndef PROBE_DUP
#define PROBE_DUP 0
#endif
#ifndef MK_MULTI_LAUNCH
#define MK_MULTI_LAUNCH 0
#endif
#define LAS __attribute__((address_space(3)))
typedef unsigned short bf16;
typedef float f32x4 __attribute__((ext_vector_type(4)));
typedef unsigned v4u __attribute__((ext_vector_type(4)));
typedef unsigned v2u __attribute__((ext_vector_type(2)));
typedef short bf16x8 __attribute__((ext_vector_type(8)));

constexpr int D = 1024, NP = 16384  , NS = 1024  , M = NP + NS, SEQ = 2048, DSEQ = 8, NBP = 8, NBS = 128, NB = NBP + NBS;
constexpr int FF = 2816, DC = 512, DP = 512, CW = 31, PM = 16, NMOD = 9, MODN = NMOD * D;
constexpr float EPS = 1e-6f;
constexpr size_t O_Y = 0, O_NSCP = (size_t)M * D, O_NSPP = O_NSCP + (size_t)NBP * 30 * DC, O_NSCS = O_NSPP + (size_t)NBP * 15 * DP, O_NSPS = O_NSCS + (size_t)NBS * 30 * DC;
constexpr size_t MiB = 1u << 20;
constexpr size_t WS_MOD = 1 * MiB;
constexpr size_t WS_WUP1 = 6 * MiB;
constexpr size_t WS_WDN1 = 17 * MiB;
constexpr size_t WS_WIN = 23 * MiB;
constexpr size_t WS_WOUT = 26 * MiB;
constexpr size_t WS_WUP2 = 28 * MiB;
constexpr size_t WS_WDN2 = 39 * MiB;
constexpr size_t WS_WADA = 45 * MiB;
constexpr size_t WS_SC = 63 * MiB;
constexpr size_t WS_A = 64 * MiB;
constexpr size_t WS_ACT = 98 * MiB;
constexpr size_t WS_END = 192 * MiB;
constexpr int LDS_BYTES = 147456;
constexpr int BAR_LDS_OFF = 131072 + 256;

__device__ __forceinline__ unsigned f2bf(float f) { unsigned u = __builtin_bit_cast(unsigned, f); return (u + 0x7fffu + ((u >> 16) & 1u)) >> 16; }
__device__ __forceinline__ unsigned pk2(float lo, float hi) { return f2bf(lo) | (f2bf(hi) << 16); }
__device__ __forceinline__ float bf2f(bf16 b) { return __builtin_bit_cast(float, (unsigned)b << 16); }
__device__ __forceinline__ float wave_sum(float v) {
#pragma unroll
    for (int o = 1; o < 64; o <<= 1) v += __shfl_xor(v, o);
    return v;
}
#define LDS_WAIT() asm volatile("s_waitcnt lgkmcnt(0)" ::: "memory")
#define XB_TMO      128
#define XB_XCNT(j)  (256  + 64 * (j))
#define XB_XSUB(j)  (1280 + 64 * (j))
#define XB_XGEN(j)  (2304 + 64 * (j))
#define XB_TOP      3328
#define XB_TOPGEN   3392
#define XCD_BAR_WORDS 3456
#define XB_SPIN_CAP (1u << 18)

__device__ __forceinline__ unsigned xb_ld(unsigned* p)              { return __hip_atomic_load(p, __ATOMIC_RELAXED, __HIP_MEMORY_SCOPE_AGENT); }
__device__ __forceinline__ unsigned xb_add(unsigned* p, unsigned v) { return __hip_atomic_fetch_add(p, v, __ATOMIC_RELAXED, __HIP_MEMORY_SCOPE_AGENT); }
__device__ __forceinline__ unsigned xb_xcc_id() { return (unsigned)__builtin_amdgcn_s_getreg((3 << 11) | 20) & 0xFu; }
#define XB_SPIN(cond, bar) do { unsigned _sp = 0; while (cond) { __builtin_amdgcn_s_sleep(1); \
    if ((++_sp & 255u) == 0u) { if (xb_ld(&(bar)[XB_TMO])) break; if (_sp > XB_SPIN_CAP) { atomicAdd(&(bar)[XB_TMO], 1u); break; } } } } while (0)

struct XcdBarrier {
    unsigned* bar; unsigned x;
    volatile LAS unsigned* st;
};

__device__ __forceinline__ XcdBarrier xcd_barrier_post(unsigned* bar, volatile LAS unsigned* st) {
    XcdBarrier b; b.bar = bar; b.x = xb_xcc_id(); b.st = st;
    if (threadIdx.x == 0) (void)xb_add(&bar[XB_XCNT(b.x)], 1u);
    return b;
}
__device__ __forceinline__ void xcd_barrier_complete(unsigned* bar, unsigned x, unsigned& nloc, unsigned& nx) {
    const unsigned G = gridDim.x * gridDim.y * gridDim.z;
    unsigned sum, cnt, mine, sp = 0u;
    for (;;) {
        sum = 0u; cnt = 0u; mine = 0u;
#pragma unroll
        for (unsigned j = 0; j < 16; ++j) { const unsigned c = xb_ld(&bar[XB_XCNT(j)]); sum += c; cnt += (c > 0u) ? 1u : 0u; mine = (j == x) ? c : mine; }
        if (sum == G) break;
        __builtin_amdgcn_s_sleep(1);
        if ((++sp & 255u) == 0u) { if (xb_ld(&bar[XB_TMO])) break; if (sp > XB_SPIN_CAP) { atomicAdd(&bar[XB_TMO], 1u); break; } }
    }
    nloc = mine > 0u ? mine : 1u; nx = cnt > 0u ? cnt : 1u;
}

__device__ __forceinline__ void xcd_barrier(const XcdBarrier& b) {
    asm volatile("s_waitcnt vmcnt(0)" ::: "memory");
    __syncthreads();
    if (threadIdx.x == 0) {
        unsigned* bar = b.bar;
        __builtin_amdgcn_s_waitcnt(0);
        unsigned nloc = b.st[0], nx = b.st[1];
        if (nloc == 0u) { xcd_barrier_complete(bar, b.x, nloc, nx); b.st[0] = nloc; b.st[1] = nx; }
        const unsigned old = xb_add(&bar[XB_XSUB(b.x)], 1u);
        const unsigned gen = old / nloc;
        if (old + 1u == (gen + 1u) * nloc) {
            __builtin_amdgcn_fence(__ATOMIC_RELEASE, "agent");
            asm volatile("s_waitcnt vmcnt(0)" ::: "memory");
            const unsigned og = xb_add(&bar[XB_TOP], 1u);
            const unsigned tg = og / nx;
            if (og + 1u == (tg + 1u) * nx) xb_add(&bar[XB_TOPGEN], 1u);
            else XB_SPIN(xb_ld(&bar[XB_TOPGEN]) == tg, bar);
            __builtin_amdgcn_fence(__ATOMIC_ACQUIRE, "agent");
            xb_add(&bar[XB_XGEN(b.x)], 1u);
            asm volatile("s_waitcnt vmcnt(0)" ::: "memory");
        } else {
            XB_SPIN(xb_ld(&bar[XB_XGEN(b.x)]) == gen, bar);
            __builtin_amdgcn_fence(__ATOMIC_ACQUIRE, "agent");
            asm volatile("s_waitcnt vmcnt(0)" ::: "memory");
        }
    }
    __syncthreads();
}

struct Args { const float* in[24]; float* out; unsigned char* ws; int ph_lo, ph_hi; };
enum { I_XP = 0, I_XS, I_SCONV, I_SPOOL, I_CP, I_CS, I_WADA, I_BADA, I_G1, I_WUP1, I_WDN1, I_GM, I_WIN, I_WDW, I_BDW, I_LNG, I_LNB, I_WPOOL, I_PSCALE, I_WOUT, I_G2, I_WUP2, I_WDN2, I_GF };

__device__ __forceinline__ void transpose_item(const float* W, int ldw, bf16* WT, int ldt, int k0, int n0, int drow0, LAS float* scr, int lane) {
#pragma unroll 8
    for (int i = 0; i < 32; ++i) { const int kk = 2 * i + (lane >> 5); scr[kk * 33 + (lane & 31)] = W[(size_t)(k0 + kk) * ldw + n0 + (lane & 31)]; }
    LDS_WAIT(); asm volatile("" ::: "memory");
    const int c = lane & 7;
#pragma unroll
    for (int j = 0; j < 4; ++j) { const int n = (lane >> 3) + 8 * j; const LAS float* s = scr + (8 * c) * 33 + n;
        v4u o; o.x = pk2(s[0 * 33], s[1 * 33]); o.y = pk2(s[2 * 33], s[3 * 33]); o.z = pk2(s[4 * 33], s[5 * 33]); o.w = pk2(s[6 * 33], s[7 * 33]);
        *(v4u*)(WT + (size_t)(drow0 + n) * ldt + k0 + 8 * c) = o; }
    LDS_WAIT(); asm volatile("" ::: "memory");
}
__device__ __forceinline__ int pair_row(int n, int half) { const int sec = n >= half ? 1 : 0, j = n - sec * half; return (j >> 7) * 256 + sec * 128 + (j & 127); }

__device__ __forceinline__ void p0_prologue(const Args& a, LAS unsigned char* lds, int G) {
    const int tid = threadIdx.x, lane = tid & 63, wave = __builtin_amdgcn_readfirstlane(tid >> 6);
    unsigned char* ws = a.ws;
    LAS float* scr = (LAS float*)(lds + wave * 16384);
    const int gw = blockIdx.x * 8 + wave, NGW = G * 8;
    constexpr int I_UP = (D / 64) * (2 * FF / 32), I_DN = (FF / 64) * (D / 32), I_IN = (D / 64) * (1536 / 32), I_OUT = (512 / 64) * (D / 32), I_ADA = (D / 64) * (MODN / 32);
    constexpr int NITEMS = 2 * I_UP + 2 * I_DN + I_IN + I_OUT + I_ADA;
    for (int it = gw; it < NITEMS; it += NGW) {
        int r = it;
        if (r < I_ADA) { const int nblk = MODN / 32, kb = r / nblk, nb = r % nblk; transpose_item(a.in[I_WADA], MODN, (bf16*)(ws + WS_WADA), D, kb * 64, nb * 32, nb * 32, scr, lane); continue; } r -= I_ADA;
        if (r < 2 * I_UP) { const int l = r >= I_UP; r -= l * I_UP; const int nblk = 2 * FF / 32, kb = r / nblk, nb = r % nblk;
            transpose_item(a.in[l ? I_WUP2 : I_WUP1], 2 * FF, (bf16*)(ws + (l ? WS_WUP2 : WS_WUP1)), D, kb * 64, nb * 32, pair_row(nb * 32, FF), scr, lane); continue; } r -= 2 * I_UP;
        if (r < 2 * I_DN) { const int l = r >= I_DN; r -= l * I_DN; const int nblk = D / 32, kb = r / nblk, nb = r % nblk;
            transpose_item(a.in[l ? I_WDN2 : I_WDN1], D, (bf16*)(ws + (l ? WS_WDN2 : WS_WDN1)), FF, kb * 64, nb * 32, nb * 32, scr, lane); continue; } r -= 2 * I_DN;
        if (r < I_IN) { const int nblk = 1536 / 32, kb = r / nblk, nb = r % nblk, n0 = nb * 32;
            transpose_item(a.in[I_WIN], 1536, (bf16*)(ws + WS_WIN), D, kb * 64, n0, n0 < 1024 ? pair_row(n0, 512) : n0, scr, lane); continue; } r -= I_IN;
        { const int nblk = D / 32, kb = r / nblk, nb = r % nblk; transpose_item(a.in[I_WOUT], D, (bf16*)(ws + WS_WOUT), D, kb * 64, nb * 32, nb * 32, scr, lane); }
    }
    const int gt = blockIdx.x * 512 + tid, NGT = G * 512;
    for (int i = gt; i < 144 * D / 4; i += NGT) { const int row = i / (D / 4), c4 = i % (D / 4);
        f32x4 v = (f32x4){0.f, 0.f, 0.f, 0.f};
        if (row < NBP) v = *(const f32x4*)(a.in[I_CP] + (size_t)row * D + c4 * 4); else if (row < NB) v = *(const f32x4*)(a.in[I_CS] + (size_t)(row - NBP) * D + c4 * 4);
        v2u o; o.x = pk2(v[0] * pg8::sigmoid_f(v[0]), v[1] * pg8::sigmoid_f(v[1])); o.y = pk2(v[2] * pg8::sigmoid_f(v[2]), v[3] * pg8::sigmoid_f(v[3]));
        *(v2u*)((bf16*)(ws + WS_SC) + (size_t)row * D + c4 * 4) = o; }
    for (int it = gt; it < 1024 * 64; it += NGT) { const int n = it & 1023, gc = it >> 10, g = gc >> 4, c8 = gc & 15;
        float acc[8];
#pragma unroll
        for (int i = 0; i < 8; ++i) acc[i] = 0.f;
        const float* wo = a.in[I_WOUT] + (size_t)(512 + 128 * g) * D + n; const float* ps = a.in[I_PSCALE] + 128 * g; const float* wp = a.in[I_WPOOL] + (size_t)(g * 128 + c8 * 8) * 128;
#pragma unroll 4
        for (int d = 0; d < 128; ++d) { const float w = wo[(size_t)d * D] * ps[d];
#pragma unroll
            for (int i = 0; i < 8; ++i) acc[i] = __builtin_fmaf(wp[i * 128 + d], w, acc[i]); }
        v4u o; o.x = pk2(acc[0], acc[1]); o.y = pk2(acc[2], acc[3]); o.z = pk2(acc[4], acc[5]); o.w = pk2(acc[6], acc[7]);
        *(v4u*)((bf16*)(ws + WS_WOUT) + (size_t)n * D + 512 + 128 * g + c8 * 8) = o; }
}

__device__ __forceinline__ void p1_mod(const Args& a, int G) {
    const int tid = threadIdx.x, lane = tid & 63, wave = __builtin_amdgcn_readfirstlane(tid >> 6), fr = lane & 15, fq = lane >> 4;
    const bf16* Wt = (const bf16*)(a.ws + WS_WADA); const bf16* SC = (const bf16*)(a.ws + WS_SC); float* mod = (float*)(a.ws + WS_MOD);
    const int gw = blockIdx.x * 8 + wave, NGW = G * 8;
    for (int item = gw; item < (MODN / 16) * 3; item += NGW) {
        const int nt = item / 3, bg = item % 3, n0 = nt * 16, b0 = bg * 48;
        f32x4 acc[3];
#pragma unroll
        for (int i = 0; i < 3; ++i) acc[i] = (f32x4){0.f, 0.f, 0.f, 0.f};
        const bf16* wp = Wt + (size_t)(n0 + fr) * D + fq * 8; const bf16* sp = SC + (size_t)(b0 + fr) * D + fq * 8;
#pragma unroll 4
        for (int ks = 0; ks < D / 32; ++ks) { const bf16x8 wf = *(const bf16x8*)(wp + ks * 32);
#pragma unroll
            for (int i = 0; i < 3; ++i) { const bf16x8 sf = *(const bf16x8*)(sp + (size_t)i * 16 * D + ks * 32); acc[i] = __builtin_amdgcn_mfma_f32_16x16x32_bf16(wf, sf, acc[i], 0, 0, 0); } }
        const int n = n0 + 4 * fq, slot = n >> 10, col = n & 1023, kind = slot % 3;
        const f32x4 bias = *(const f32x4*)(a.in[I_BADA] + n);
        f32x4 gv = (f32x4){1.f, 1.f, 1.f, 1.f};
        if (kind == 1) gv = *(const f32x4*)(a.in[slot == 1 ? I_G1 : (slot == 4 ? I_GM : I_G2)] + col);
        const float gs = (slot == 2 || slot == 8) ? 0.5f : 1.0f;
#pragma unroll
        for (int i = 0; i < 3; ++i) { const int b = b0 + 16 * i + fr; f32x4 v = acc[i] + bias;
            if (kind == 1) v = gv * (v + 1.0f); else if (kind == 2) v = v * gs;
            if (b < NB) *(f32x4*)(mod + (size_t)b * MODN + n) = v; }
    }
}

template <bool FROM_X> __device__ __forceinline__ void norm_phase(const Args& a, int G, int slot_shift) {
    const int tid = threadIdx.x, lane = tid & 63, wave = __builtin_amdgcn_readfirstlane(tid >> 6);
    const float* mod = (const float*)(a.ws + WS_MOD); bf16* A = (bf16*)(a.ws + WS_A);
    const int gw = blockIdx.x * 8 + wave, NGW = G * 8;
    for (int row = gw; row < M; row += NGW) {
        const float* src = FROM_X ? (row < NP ? a.in[I_XP] + (size_t)row * D : a.in[I_XS] + (size_t)(row - NP) * D) : a.out + (size_t)row * D;
        const f32x4* xr = (const f32x4*)src + lane;
        f32x4 v[4]; float s = 0.f;
#pragma unroll
        for (int j = 0; j < 4; ++j) { v[j] = xr[64 * j]; s += (v[j].x * v[j].x + v[j].y * v[j].y) + (v[j].z * v[j].z + v[j].w * v[j].w); }
        const float r = 1.0f / sqrtf(wave_sum(s) * (1.0f / D) + EPS);
        const float* mrow = mod + (size_t)pg8::mod_row(row) * MODN + (size_t)slot_shift * D;
        const f32x4* sh = (const f32x4*)mrow + lane; const f32x4* cs = (const f32x4*)(mrow + D) + lane;
        v2u* o8 = (v2u*)(A + (size_t)row * D) + lane;
#pragma unroll
        for (int j = 0; j < 4; ++j) { const f32x4 c = cs[64 * j], h = sh[64 * j]; const f32x4 y = v[j] * r * c + h; v2u o; o.x = pk2(y.x, y.y); o.y = pk2(y.z, y.w); o8[64 * j] = o; }
    }
}
__device__ __forceinline__ void final_norm_phase(const Args& a, int G) {
    const int tid = threadIdx.x, lane = tid & 63, wave = __builtin_amdgcn_readfirstlane(tid >> 6);
    const int gw = blockIdx.x * 8 + wave, NGW = G * 8;
    const f32x4* gf = (const f32x4*)a.in[I_GF] + lane;
    for (int row = gw; row < M; row += NGW) {
        f32x4* xr = (f32x4*)(a.out + (size_t)row * D) + lane;
        f32x4 v[4]; float s = 0.f;
#pragma unroll
        for (int j = 0; j < 4; ++j) { v[j] = xr[64 * j]; s += (v[j].x * v[j].x + v[j].y * v[j].y) + (v[j].z * v[j].z + v[j].w * v[j].w); }
        const float r = 1.0f / sqrtf(wave_sum(s) * (1.0f / D) + EPS);
#pragma unroll
        for (int j = 0; j < 4; ++j) xr[64 * j] = v[j] * r * gf[64 * j];
    }
}

constexpr int MIX_CONV_ROWS = 46, MIX_POOL_ROWS = 31, MIX_POOL_OFF = MIX_CONV_ROWS * 1024, MIX_V_OFF = MIX_POOL_OFF + MIX_POOL_ROWS * 1024, MIX_NU = NS / 16 + NP / 16;
#define MIX_DECODE(u_, prompt_, b_, t0_, row0_) const bool prompt_ = (u_) >= NS / 16; const int b_ = prompt_ ? ((u_) - NS / 16) / (SEQ / 16) : (u_) * 2, t0_ = prompt_ ? (((u_) - NS / 16) % (SEQ / 16)) * 16 : 0, row0_ = prompt_ ? b_ * SEQ + t0_ : NP + (u_) * 16
#define MIX_LOAD(u_) do { MIX_DECODE(u_, p_, bb_, tt0_, r0_); (void)p_; (void)bb_; (void)tt0_; \
        _Pragma("unroll") for (int k = 0; k < 6; ++k) { const int q = tid + 512 * k; if (q < MIX_CONV_ROWS * 64) pc[k] = *(const v4u*)(U + (long)(r0_ - 30 + (q >> 6)) * D + (q & 63) * 8); } \
        _Pragma("unroll") for (int k = 0; k < 4; ++k) { const int q = tid + 512 * k; if (q < MIX_POOL_ROWS * 64) pp[k] = *(const v4u*)(U + (long)(r0_ - 15 + (q >> 6)) * D + DC + (q & 63) * 8); } } while (0)
__device__ __forceinline__ void mixer_phase(const Args& a, LAS unsigned char* lds, int G) {
    const int tid = threadIdx.x, lane = tid & 63, wave = __builtin_amdgcn_readfirstlane(tid >> 6), c = tid;
    const bf16* U = (const bf16*)(a.ws + WS_ACT); bf16* A = (bf16*)(a.ws + WS_A);
    LAS bf16* convT = (LAS bf16*)lds; LAS bf16* poolT = (LAS bf16*)(lds + MIX_POOL_OFF); LAS float* vbuf = (LAS float*)(lds + MIX_V_OFF);
    float wdw[CW];
#pragma unroll
    for (int k = 0; k < CW; ++k) wdw[k] = a.in[I_WDW][k * DC + c];
    const float bdw = a.in[I_BDW][c];
    const int gi = c >> 7, win = 2 << gi;
    v4u pc[6], pp[4];
    int uidx = blockIdx.x;
    if (uidx < MIX_NU) MIX_LOAD(uidx);
    for (; uidx < MIX_NU; uidx += G) {
#pragma unroll
        for (int k = 0; k < 6; ++k) { const int q = tid + 512 * k; if (q < MIX_CONV_ROWS * 64) *(LAS v4u*)(convT + (q >> 6) * 512 + (q & 63) * 8) = pc[k]; }
#pragma unroll
        for (int k = 0; k < 4; ++k) { const int q = tid + 512 * k; if (q < MIX_POOL_ROWS * 64) *(LAS v4u*)(poolT + (q >> 6) * 512 + (q & 63) * 8) = pp[k]; }
        LDS_WAIT(); __syncthreads();
        if (uidx + G < MIX_NU) MIX_LOAD(uidx + G);
        MIX_DECODE(uidx, prompt, b0, t0, row0);
#pragma unroll 1
        for (int g = 0; g < 2; ++g) {
            const int tb = t0 + g * 8, b = prompt ? b0 : b0 + g;
            float in[38];
            { const LAS bf16* tp = convT + (g * 8) * 512 + c;
                if (prompt) {
                    if (tb >= 30) {
#pragma unroll
                        for (int i = 0; i < 38; ++i) in[i] = bf2f(tp[i * 512]);
                    } else {
#pragma unroll
                        for (int i = 0; i < 38; ++i) { const float x = bf2f(tp[i * 512]); in[i] = (tb - 30 + i >= 0) ? x : 0.f; }
                    }
                } else {
                    const float* st = a.in[I_SCONV] + (size_t)b * 30 * DC + c;
#pragma unroll
                    for (int i = 0; i < 30; ++i) in[i] = st[i * DC];
#pragma unroll
                    for (int i = 30; i < 38; ++i) in[i] = bf2f(tp[i * 512]);
                } }
#pragma unroll
            for (int tt = 0; tt < 8; ++tt) { float s = bdw;
#pragma unroll
                for (int k = 0; k < CW; ++k) s = __builtin_fmaf(wdw[k], in[tt + k], s);
                vbuf[(g * 8 + tt) * DC + c] = s; }
            if (prompt) { if (tb + 8 > SEQ - 30) {
#pragma unroll
                    for (int tt = 0; tt < 8; ++tt) if (tb + tt >= SEQ - 30) a.out[O_NSCP + (size_t)(b * 30 + tb + tt - (SEQ - 30)) * DC + c] = in[30 + tt]; }
            } else { float* o = a.out + O_NSCS + (size_t)b * 30 * DC + c;
#pragma unroll
                for (int e = 8; e < 38; ++e) o[(e - 8) * DC] = in[e]; }
            float pin[23];
            { const LAS bf16* tp = poolT + (g * 8) * 512 + c;
                if (prompt) {
                    if (tb >= 15) {
#pragma unroll
                        for (int i = 0; i < 23; ++i) pin[i] = bf2f(tp[i * 512]);
                    } else {
#pragma unroll
                        for (int i = 0; i < 23; ++i) { const float x = bf2f(tp[i * 512]); pin[i] = (tb - 15 + i >= 0) ? x : 0.f; }
                    }
                } else {
                    const float* st = a.in[I_SPOOL] + (size_t)b * 15 * DP + c;
#pragma unroll
                    for (int i = 0; i < 15; ++i) pin[i] = st[i * DP];
#pragma unroll
                    for (int i = 15; i < 23; ++i) pin[i] = bf2f(tp[i * 512]);
                } }
#pragma unroll
            for (int tt = 0; tt < 8; ++tt) { const float cur = pin[15 + tt];
                const float s2 = cur + pin[14 + tt], s4 = s2 + (pin[13 + tt] + pin[12 + tt]), s8 = s4 + ((pin[11 + tt] + pin[10 + tt]) + (pin[9 + tt] + pin[8 + tt]));
                const float s16 = s8 + (((pin[7 + tt] + pin[6 + tt]) + (pin[5 + tt] + pin[4 + tt])) + ((pin[3 + tt] + pin[2 + tt]) + (pin[1 + tt] + pin[0 + tt])));
                const float s = gi == 0 ? s2 : (gi == 1 ? s4 : (gi == 2 ? s8 : s16));
                const int cnt = prompt ? (tb + tt + 1 < win ? tb + tt + 1 : win) : win;
                A[(size_t)(row0 + g * 8 + tt) * D + DC + c] = (bf16)f2bf(s / (float)cnt - cur); }
            if (prompt) { if (tb + 8 > SEQ - 15) {
#pragma unroll
                    for (int tt = 0; tt < 8; ++tt) if (tb + tt >= SEQ - 15) a.out[O_NSPP + (size_t)(b * 15 + tb + tt - (SEQ - 15)) * DP + c] = pin[15 + tt]; }
            } else { float* o = a.out + O_NSPS + (size_t)b * 15 * DP + c;
#pragma unroll
                for (int e = 8; e < 23; ++e) o[(e - 8) * DP] = pin[e]; }
        }
        LDS_WAIT(); __syncthreads();
#pragma unroll
        for (int h = 0; h < 2; ++h) { const int tk = wave + 8 * h;
            const LAS float* vr = vbuf + tk * DC + lane * 8; const f32x4 x0 = *(const LAS f32x4*)vr, x1 = *(const LAS f32x4*)(vr + 4);
            const float mean = wave_sum((x0.x + x0.y) + (x0.z + x0.w) + (x1.x + x1.y) + (x1.z + x1.w)) * (1.0f / DC);
            const f32x4 d0 = x0 - mean, d1 = x1 - mean;
            const float var = wave_sum((d0.x * d0.x + d0.y * d0.y) + (d0.z * d0.z + d0.w * d0.w) + (d1.x * d1.x + d1.y * d1.y) + (d1.z * d1.z + d1.w * d1.w)) * (1.0f / DC);
            const float rstd = 1.0f / sqrtf(var + EPS);
            const f32x4 g0 = *(const f32x4*)(a.in[I_LNG] + lane * 8), g1 = *(const f32x4*)(a.in[I_LNG] + lane * 8 + 4), b0v = *(const f32x4*)(a.in[I_LNB] + lane * 8), b1v = *(const f32x4*)(a.in[I_LNB] + lane * 8 + 4);
            f32x4 y0 = d0 * rstd * g0 + b0v, y1 = d1 * rstd * g1 + b1v;
#pragma unroll
            for (int j = 0; j < 4; ++j) { y0[j] = y0[j] * pg8::sigmoid_f(y0[j]); y1[j] = y1[j] * pg8::sigmoid_f(y1[j]); }
            v4u o; o.x = pk2(y0.x, y0.y); o.y = pk2(y0.z, y0.w); o.z = pk2(y1.x, y1.y); o.w = pk2(y1.z, y1.w);
            *(v4u*)(A + (size_t)(row0 + tk) * D + lane * 8) = o; }
        LDS_WAIT(); __syncthreads();
    }
}
#undef MIX_LOAD
#undef MIX_DECODE

constexpr int N_PHASES = 13;
__global__ void __launch_bounds__(512, 2) fwd_megakernel(Args args) {
    extern __shared__ __attribute__((aligned(16))) unsigned char lds_raw[];
    LAS unsigned char* lds = (LAS unsigned char*)lds_raw;
    const int G = gridDim.x, lo = args.ph_lo, hi = args.ph_hi;
    unsigned char* ws = args.ws;
    float* mod = (float*)(ws + WS_MOD);
    bf16* Abuf = (bf16*)(ws + WS_A); bf16* ACT = (bf16*)(ws + WS_ACT);
#define IN(k) (lo <= (k) && (k) < hi)
    volatile LAS unsigned* bst = (volatile LAS unsigned*)(lds + BAR_LDS_OFF);
    if (threadIdx.x < 4) bst[threadIdx.x] = 0u;
    __syncthreads();
    XcdBarrier bar; bar.bar = (unsigned*)ws; bar.x = 0; bar.st = nullptr;
    if (!MK_MULTI_LAUNCH) bar = xcd_barrier_post((unsigned*)ws, bst);
    if (hi > N_PHASES) cg::this_grid().sync();
#if MK_MULTI_LAUNCH
#define SEAM(k) do { } while (0)
#else
#define SEAM(k) do { if (IN(k) && IN((k) + 1)) xcd_barrier(bar); } while (0)
#endif
    if (IN(0)) for (int rep_ = 0; rep_ <= ((PROBE_DUP >> 0) & 1); ++rep_) { p0_prologue(args, lds, G); } SEAM(0);
    if (IN(1)) for (int rep_ = 0; rep_ <= ((PROBE_DUP >> 1) & 1); ++rep_) { p1_mod(args, G); } SEAM(1);
    if (IN(2)) for (int rep_ = 0; rep_ <= ((PROBE_DUP >> 2) & 1); ++rep_) { norm_phase<true>(args, G, 0); } SEAM(2);
    if (IN(3)) for (int rep_ = 0; rep_ <= ((PROBE_DUP >> 3) & 1); ++rep_) { pg8::Gemm g{Abuf, (const bf16*)(ws + WS_WUP1), M, 2 * FF, D}; pg8::StaticOrder S; S.init(M, 2 * FF, G, (int)blockIdx.x);
        pg8::EpiGate<0> E{ACT, FF}; pg8::gemm_phase<pg8::EpiGate<0>, pg8::StaticOrder, true, true>(lds, g, S, E); } SEAM(3);
    if (IN(4)) for (int rep_ = 0; rep_ <= ((PROBE_DUP >> 4) & 1); ++rep_) { pg8::Gemm g{ACT, (const bf16*)(ws + WS_WDN1), M, D, FF}; pg8::StaticOrder S; S.init(M, D, G, (int)blockIdx.x);
        pg8::EpiResid<true> E{args.in[I_XP], args.in[I_XS], args.out, mod + 2 * D}; pg8::gemm_phase<pg8::EpiResid<true>, pg8::StaticOrder, true, true>(lds, g, S, E); } SEAM(4);
    if (IN(5)) for (int rep_ = 0; rep_ <= ((PROBE_DUP >> 5) & 1); ++rep_) { norm_phase<false>(args, G, 3); } SEAM(5);
    if (IN(6)) for (int rep_ = 0; rep_ <= ((PROBE_DUP >> 6) & 1); ++rep_) { pg8::Gemm g{Abuf, (const bf16*)(ws + WS_WIN), M, 1536, D}; pg8::StaticOrder S; S.init(M, 1536, G, (int)blockIdx.x);
        pg8::EpiGate<1> E{ACT, D}; pg8::gemm_phase<pg8::EpiGate<1>, pg8::StaticOrder, true, true>(lds, g, S, E); } SEAM(6);
    if (IN(7)) for (int rep_ = 0; rep_ <= ((PROBE_DUP >> 7) & 1); ++rep_) { mixer_phase(args, lds, G); } SEAM(7);
    if (IN(8)) for (int rep_ = 0; rep_ <= ((PROBE_DUP >> 8) & 1); ++rep_) { pg8::Gemm g{Abuf, (const bf16*)(ws + WS_WOUT), M, D, D}; pg8::StaticOrder S; S.init(M, D, G, (int)blockIdx.x);
        pg8::EpiResid<false> E{nullptr, nullptr, args.out, mod + 5 * D}; pg8::gemm_phase<pg8::EpiResid<false>, pg8::StaticOrder, true, true>(lds, g, S, E); } SEAM(8);
    if (IN(9)) for (int rep_ = 0; rep_ <= ((PROBE_DUP >> 9) & 1); ++rep_) { norm_phase<false>(args, G, 6); } SEAM(9);
    if (IN(10)) for (int rep_ = 0; rep_ <= ((PROBE_DUP >> 10) & 1); ++rep_) { pg8::Gemm g{Abuf, (const bf16*)(ws + WS_WUP2), M, 2 * FF, D}; pg8::StaticOrder S; S.init(M, 2 * FF, G, (int)blockIdx.x);
        pg8::EpiGate<0> E{ACT, FF}; pg8::gemm_phase<pg8::EpiGate<0>, pg8::StaticOrder, true, true>(lds, g, S, E); } SEAM(10);
    if (IN(11)) for (int rep_ = 0; rep_ <= ((PROBE_DUP >> 11) & 1); ++rep_) { pg8::Gemm g{ACT, (const bf16*)(ws + WS_WDN2), M, D, FF}; pg8::StaticOrder S; S.init(M, D, G, (int)blockIdx.x);
        pg8::EpiResid<false> E{nullptr, nullptr, args.out, mod + 8 * D}; pg8::gemm_phase<pg8::EpiResid<false>, pg8::StaticOrder, true, true>(lds, g, S, E); } SEAM(11);
    if (IN(12)) for (int rep_ = 0; rep_ <= ((PROBE_DUP >> 12) & 1); ++rep_) { final_norm_phase(args, G); }
#undef IN
#undef SEAM
}

extern "C" void kernel_launch(void* const* d_in, const int* in_sizes, int n_in, void* d_out, int out_size, void* d_ws, size_t ws_size, hipStream_t stream) {
    static int grid = 0;
    if (grid == 0) {
        if (n_in != 24 || ws_size < WS_END) { fprintf(stderr, "kernel_launch: unexpected n_in %d / ws %zu\n", n_in, ws_size); grid = -1; return; }
        int dev = 0, cus = 0, per_cu = 0;
        (void)hipGetDevice(&dev); (void)hipDeviceGetAttribute(&cus, hipDeviceAttributeMultiprocessorCount, dev);
        if (hipFuncSetAttribute((const void*)fwd_megakernel, hipFuncAttributeMaxDynamicSharedMemorySize, LDS_BYTES) != hipSuccess) { fprintf(stderr, "kernel_launch: hipFuncSetAttribute failed\n"); grid = -1; return; }
        if (hipOccupancyMaxActiveBlocksPerMultiprocessor(&per_cu, (const void*)fwd_megakernel, 512, LDS_BYTES) != hipSuccess || per_cu < 1) { fprintf(stderr, "kernel_launch: occupancy query says %d blocks/CU\n", per_cu); per_cu = 1; (void)hipGetLastError(); }
        grid = cus;
        if (grid <= 0) grid = 256;
    }
    if (grid < 0) return;
    Args a{};
    for (int i = 0; i < 24; ++i) a.in[i] = (const float*)d_in[i];
    a.out = (float*)d_out; a.ws = (unsigned char*)d_ws;
#if MK_MULTI_LAUNCH
    for (int ph = 0; ph < N_PHASES; ++ph) { a.ph_lo = ph; a.ph_hi = ph + 1; hipLaunchKernelGGL(fwd_megakernel, dim3(grid), dim3(512), LDS_BYTES, stream, a); }
#else
    a.ph_lo = 0; a.ph_hi = N_PHASES;
    if (hipMemsetAsync(d_ws, 0, 16384, stream) != hipSuccess) { fprintf(stderr, "kernel_launch: memset of the barrier words failed\n"); return; }
    void* kargs[] = {&a};
    hipError_t e = hipLaunchCooperativeKernel((const void*)fwd_megakernel, dim3(grid), dim3(512), kargs, LDS_BYTES, stream);
    if (e != hipSuccess) fprintf(stderr, "kernel_launch: cooperative launch failed: %s (grid %d)\n", hipGetErrorString(e), grid);
#endif
}
```

```cpp
#include <hip/hip_runtime.h>
#include <hip/hip_cooperative_groups.h>
#include <cstdio>
#include <cstdint>
namespace cg = cooperative_groups;
#define MK_MULTI_LAUNCH 0
namespace pg8 {
#define PG8_LAS __attribute__((address_space(3)))
typedef unsigned short bf16_t;
typedef short bf16x8 __attribute__((ext_vector_type(8)));
typedef float f32x4 __attribute__((ext_vector_type(4)));
typedef unsigned u32x4 __attribute__((ext_vector_type(4)));
constexpr int BM = 256, BK = 64, HALF = 128, HTB = HALF * BK * 2  , STAGE_BYTES = 8 * HTB, NXCD = 8, WGM = 8;

__host__ __device__ __forceinline__ int lds_byte(int r, int c) { const int st = (r >> 4) * 2 + (c >> 5), rr = r & 15, cc = c & 31, ob = rr * 64 + cc * 2; return st * 1024 + (ob ^ (((ob >> 9) & 1) << 5)); }
__host__ __device__ __forceinline__ void stage_rc(int b, int& R, int& C) { const int st = b / 1024, sb = b % 1024, swz = sb ^ (((sb >> 9) & 1) << 5); R = (st >> 1) * 16 + swz / 64; C = (st & 1) * 32 + (swz % 64) / 2; }
__host__ __device__ __forceinline__ int perm32(int rho) { const int n = rho >> 4, i = rho & 15; return 8 * (i >> 2) + 4 * n + (i & 3); }

struct Unit { int pm, pn, kt0, nkt; };
struct Gemm { const bf16_t* A; const bf16_t* Bt; int M, N, K, ta; };

struct StaticOrder {
    int nM, nN, nwg, G, c, nt;
    __host__ __device__ __forceinline__ void init(int M, int N, int G_, int c_, int K) { nM = M / BM; nN = N / BM; nwg = nM * nN; G = G_; c = c_; nt = K / BK; }
    __host__ __device__ __forceinline__ bool next(int i, Unit& u) const {
        const long L = (long)i * G + c; if (L >= nwg) return false;
        int wgid = (int)L; { const int q = nwg / NXCD, r = nwg % NXCD, xcd = wgid % NXCD, off = wgid / NXCD; wgid = (xcd < r ? xcd * (q + 1) : r * (q + 1) + (xcd - r) * q) + off; }
        const int nig = WGM * nN, gid = wgid / nig, fm = gid * WGM, gsz = (nM - fm) < WGM ? (nM - fm) : WGM;
        u.pm = fm + ((wgid % nig) % gsz); u.pn = (wgid % nig) / gsz; u.kt0 = 0; u.nkt = nt; return true;
    }
    __device__ __forceinline__ void a_ready(const Unit&) const {}
    __device__ __forceinline__ void done(const Unit&) const {}
};
struct SplitOrder : StaticOrder {
    int pm0, npieces, ppu, pk, npc;
    __host__ __device__ __forceinline__ void init(int Mfull, int Mtot, int N, int G_, int c_, int K, int pk_) { StaticOrder::init(Mfull, N, G_, c_, K); pm0 = Mfull / BM; pk = pk_; ppu = nt / pk; npieces = ((Mtot - Mfull) / BM) * nN * ppu;
        npc = c < npieces ? (npieces - c + G - 1) / G : 0; }
    __host__ __device__ __forceinline__ bool next(int i, Unit& u) const {
        if (i >= npc) return StaticOrder::next(i - npc, u);
        const int p = i * G + c; const int up = p / ppu, kp = p - up * ppu; u.pm = pm0 + up / nN; u.pn = up % nN; u.kt0 = kp * pk; u.nkt = pk; return true;
    }
};
__device__ __forceinline__ unsigned cvt_pk_bf16(float lo, float hi) { unsigned r; asm volatile("v_cvt_pk_bf16_f32 %0, %1, %2" : "=v"(r) : "v"(lo), "v"(hi)); return r; }
typedef float f32x2 __attribute__((ext_vector_type(2)));
constexpr int NROW_PROMPT = 16384, MODLD = 9216, DM = 1024;
__device__ __forceinline__ int mod_row(int r) { return r < NROW_PROMPT ? (r >> 11) : 8 + ((r - NROW_PROMPT) >> 3); }
__device__ __forceinline__ float sigmoid_f(float g) { return __builtin_amdgcn_rcpf(1.0f + __builtin_amdgcn_exp2f(-1.44269504089f * g)); }

template <int MODE> struct EpiGate {
    static constexpr bool PERM = true, AFTER_DRAIN = false;
    bf16_t* O; int ldc; int tiled;
    __device__ __forceinline__ void operator()(const f32x4 (&acc)[2][2][4][2], const Unit& u, int wr, int wc, int fr, int fq) const {
        const int row0 = u.pm * BM + wr * 64 + fr;
        if (MODE == 0 || u.pn < 4) {
            const int col0 = u.pn * 128 + wc * 32 + 8 * fq;
#pragma unroll
            for (int ai = 0; ai < 2; ++ai)
#pragma unroll
                for (int m = 0; m < 4; ++m) { const int rr = wr * 64 + fr + ai * HALF + m * 16;
                    bf16_t* rowp = tiled ? O + (size_t)(u.pm * (ldc >> 6) + (col0 >> 6)) * (BM * BK) + ai * (HALF * BK) + (lds_byte(rr & 127, col0 & 63) >> 1) : O + (size_t)(row0 + ai * HALF + m * 16) * ldc + col0;
                    f32x2 o[4];
#pragma unroll
                    for (int n = 0; n < 2; ++n)
#pragma unroll
                        for (int j = 0; j < 2; ++j) { const f32x2 a = (f32x2){acc[ai][0][m][n][2 * j], acc[ai][0][m][n][2 * j + 1]}, b = (f32x2){acc[ai][1][m][n][2 * j], acc[ai][1][m][n][2 * j + 1]};
                            const f32x2 x = (MODE == 0) ? a : b, t = x * (-1.44269504089f); f32x2 e; e.x = __builtin_amdgcn_exp2f(t.x); e.y = __builtin_amdgcn_exp2f(t.y);
                            const f32x2 d = e + 1.0f; f32x2 r; r.x = __builtin_amdgcn_rcpf(d.x); r.y = __builtin_amdgcn_rcpf(d.y);
                            o[n * 2 + j] = (MODE == 0) ? (a * r) * b : a * r; }
                    u32x4 w; w.x = cvt_pk_bf16(o[0].x, o[0].y); w.y = cvt_pk_bf16(o[1].x, o[1].y); w.z = cvt_pk_bf16(o[2].x, o[2].y); w.w = cvt_pk_bf16(o[3].x, o[3].y);
                    *(u32x4*)rowp = w; }
        } else {
            const int col0 = 512 + (u.pn - 4) * 256 + wc * 32 + 8 * fq;
#pragma unroll
            for (int ai = 0; ai < 2; ++ai)
#pragma unroll
                for (int m = 0; m < 4; ++m) { bf16_t* rowp = O + (size_t)(row0 + ai * HALF + m * 16) * ldc + col0;
#pragma unroll
                    for (int bj = 0; bj < 2; ++bj) { const f32x4 v0 = acc[ai][bj][m][0], v1 = acc[ai][bj][m][1];
                        u32x4 w; w.x = cvt_pk_bf16(v0[0], v0[1]); w.y = cvt_pk_bf16(v0[2], v0[3]); w.z = cvt_pk_bf16(v1[0], v1[1]); w.w = cvt_pk_bf16(v1[2], v1[3]);
                        *(u32x4*)(rowp + bj * HALF) = w; } }
        }
    }
};
template <bool FROM_X> struct EpiResid {
    static constexpr bool PERM = false, AFTER_DRAIN = false;
    const float* xp; float* h; const float* gate; float* part; int pk;
    __device__ __forceinline__ void operator()(const f32x4 (&acc)[2][2][4][2], const Unit& u, int wr, int wc, int fr, int fq) const {
        const int col0 = u.pn * BM + wc * 32 + 4 * fq;
        if (u.pm * BM >= NROW_PROMPT) {
            float* pbase = part + (size_t)(u.kt0 / pk) * (1024 * DM) + col0;
#pragma unroll
            for (int ai = 0; ai < 2; ++ai)
#pragma unroll
                for (int m = 0; m < 4; ++m) { const int row = u.pm * BM - NROW_PROMPT + ai * HALF + wr * 64 + m * 16 + fr; float* o = pbase + (size_t)row * DM;
#pragma unroll
                    for (int bj = 0; bj < 2; ++bj)
#pragma unroll
                        for (int n = 0; n < 2; ++n) *(f32x4*)(o + bj * HALF + n * 16) = acc[ai][bj][m][n]; }
            return;
        }
#pragma unroll
        for (int ai = 0; ai < 2; ++ai)
#pragma unroll
            for (int m = 0; m < 4; ++m) { const int row = u.pm * BM + ai * HALF + wr * 64 + m * 16 + fr;
                const float* gt = gate + (size_t)(row >> 11) * MODLD + col0;
                const float* base = (FROM_X ? xp + (size_t)row * DM : h + (size_t)row * DM) + col0;
                float* o = h + (size_t)row * DM + col0;
#pragma unroll
                for (int bj = 0; bj < 2; ++bj)
#pragma unroll
                    for (int n = 0; n < 2; ++n) { const int off = bj * HALF + n * 16; const f32x4 b = *(const f32x4*)(base + off), g = *(const f32x4*)(gt + off);
                        *(f32x4*)(o + off) = b + g * acc[ai][bj][m][n]; }
                asm volatile("" ::: "memory"); }
    }
};

struct RowStatX { unsigned* xbuf; unsigned* cnt; PG8_LAS unsigned char* lds; };
template <int MODE> struct EpiResidNorm {
    static constexpr bool PERM = true, AFTER_DRAIN = true;
    const float* xp; float* h; bf16_t* hb; const float* mod; int slot_gate, slot_shift; bf16_t* A; const float* gf; float* part; int pk; RowStatX X;
    static __device__ __forceinline__ u32x4 pack8(const f32x4& a, const f32x4& b) { u32x4 w; w.x = cvt_pk_bf16(a.x, a.y); w.y = cvt_pk_bf16(a.z, a.w); w.z = cvt_pk_bf16(b.x, b.y); w.w = cvt_pk_bf16(b.z, b.w); return w; }
    static __device__ __forceinline__ f32x4 lo4(const u32x4& w) { return (f32x4){__builtin_bit_cast(float, w.x << 16), __builtin_bit_cast(float, w.x & 0xffff0000u), __builtin_bit_cast(float, w.y << 16), __builtin_bit_cast(float, w.y & 0xffff0000u)}; }
    static __device__ __forceinline__ f32x4 hi4(const u32x4& w) { return (f32x4){__builtin_bit_cast(float, w.z << 16), __builtin_bit_cast(float, w.z & 0xffff0000u), __builtin_bit_cast(float, w.w << 16), __builtin_bit_cast(float, w.w & 0xffff0000u)}; }
    __device__ __forceinline__ void store_part(const f32x4 (&acc)[2][2][4][2], const Unit& u, int wr, int wc, int fr, int fq) const {
        const int col0 = u.pn * BM + wc * 32 + 8 * fq;
        bf16_t* pbase = (bf16_t*)part + (size_t)(u.kt0 / pk) * (1024 * DM) + col0;
#pragma unroll
        for (int ai = 0; ai < 2; ++ai)
#pragma unroll
            for (int m = 0; m < 4; ++m) { const int row = u.pm * BM - NROW_PROMPT + ai * HALF + wr * 64 + m * 16 + fr; bf16_t* o = pbase + (size_t)row * DM;
#pragma unroll
                for (int bj = 0; bj < 2; ++bj) *(u32x4*)(o + bj * HALF) = pack8(acc[ai][bj][m][0], acc[ai][bj][m][1]); }
    }
    __device__ __forceinline__ void operator()(const f32x4 (&acc)[2][2][4][2], const Unit& u, int wr, int wc, int fr, int fq) const { store_part(acc, u, wr, wc, fr, fq); }
    __device__ __forceinline__ void fused(const f32x4 (&acc)[2][2][4][2], const Unit& u, int wr, int wc, int fr, int fq, PG8_LAS unsigned char* stage, int wid, int lane) const {
        if (u.pm * BM >= NROW_PROMPT) { store_part(acc, u, wr, wc, fr, fq); return; }
        const int col0 = u.pn * BM + wc * 32 + 8 * fq;
        const int tid = wid * 64 + lane;
        PG8_LAS float* P = (PG8_LAS float*)X.lds; PG8_LAS float* S = (PG8_LAS float*)(X.lds + 4096);
        const float* mrow = mod + (size_t)(u.pm >> 3) * MODLD + col0;
#pragma unroll
        for (int ai = 0; ai < 2; ++ai)
#pragma unroll
            for (int m = 0; m < 4; ++m) { const int rl = ai * HALF + wr * 64 + m * 16 + fr; const size_t roff = (size_t)(u.pm * BM + rl) * DM + col0;
                float s = 0.f;
#pragma unroll
                for (int bj = 0; bj < 2; ++bj) { const int off = bj * HALF;
                    const f32x4 g0 = *(const f32x4*)(mrow + (size_t)slot_gate * DM + off), g1 = *(const f32x4*)(mrow + (size_t)slot_gate * DM + off + 4);
                    f32x4 b0, b1; if (MODE == 0) { b0 = *(const f32x4*)(xp + roff + off); b1 = *(const f32x4*)(xp + roff + off + 4); }
                    else { const u32x4 q = *(const u32x4*)(hb + roff + off); b0 = lo4(q); b1 = hi4(q); }
                    const f32x4 v0 = b0 + g0 * acc[ai][bj][m][0], v1 = b1 + g1 * acc[ai][bj][m][1];
                    const u32x4 w = pack8(v0, v1);
                    if (MODE != 2) *(u32x4*)(hb + roff + off) = w;
                    *(PG8_LAS u32x4*)(stage + (((ai * 4 + m) * 2 + bj) * 512 + tid) * 16) = w;
                    s += ((v0.x * v0.x + v0.y * v0.y) + (v0.z * v0.z + v0.w * v0.w)) + ((v1.x * v1.x + v1.y * v1.y) + (v1.z * v1.z + v1.w * v1.w));
                    asm volatile("" ::: "memory"); }
                s += __shfl_xor(s, 16); s += __shfl_xor(s, 32);
                if (fq == 0) P[rl * 4 + wc] = s;
                asm volatile("" ::: "memory"); }
        asm volatile("s_waitcnt lgkmcnt(0)" ::: "memory"); __builtin_amdgcn_s_barrier(); asm volatile("" ::: "memory");
        if (tid < 256) { const float t = (P[tid * 4 + 0] + P[tid * 4 + 1]) + (P[tid * 4 + 2] + P[tid * 4 + 3]);
            __hip_atomic_store(X.xbuf + ((size_t)(u.pm * BM + tid) * 4 + u.pn), __builtin_bit_cast(unsigned, t), __ATOMIC_RELAXED, __HIP_MEMORY_SCOPE_AGENT);
            asm volatile("s_waitcnt vmcnt(0)" ::: "memory");
            if (lane == 0) __hip_atomic_fetch_add(X.cnt + 64 * u.pm, 1u, __ATOMIC_RELAXED, __HIP_MEMORY_SCOPE_AGENT); }
        if (wid == 0) { unsigned spins = 0;
            while ((unsigned)__builtin_amdgcn_readfirstlane(__hip_atomic_load(X.cnt + 64 * u.pm, __ATOMIC_RELAXED, __HIP_MEMORY_SCOPE_AGENT)) < 16u) { __builtin_amdgcn_s_sleep(2); if (++spins > (1u << 17)) break; }
            __builtin_amdgcn_fence(__ATOMIC_ACQUIRE, "agent"); }
        asm volatile("s_waitcnt vmcnt(0) lgkmcnt(0)" ::: "memory"); __builtin_amdgcn_s_barrier(); asm volatile("" ::: "memory");
        if (tid < 256) { const unsigned* sl = X.xbuf + (size_t)(u.pm * BM + tid) * 4; float q = 0.f;
#pragma unroll
            for (int t = 0; t < 4; ++t) q += __builtin_bit_cast(float, __hip_atomic_load(sl + t, __ATOMIC_RELAXED, __HIP_MEMORY_SCOPE_AGENT));
            S[tid] = 1.0f / sqrtf(q * (1.0f / DM) + 1e-6f); }
        asm volatile("s_waitcnt vmcnt(0) lgkmcnt(0)" ::: "memory"); __builtin_amdgcn_s_barrier(); asm volatile("" ::: "memory");
#pragma unroll
        for (int ai = 0; ai < 2; ++ai)
#pragma unroll
            for (int m = 0; m < 4; ++m) { const int rl = ai * HALF + wr * 64 + m * 16 + fr; const float r = S[rl]; const size_t roff = (size_t)(u.pm * BM + rl) * DM + col0;
#pragma unroll
                for (int bj = 0; bj < 2; ++bj) { const int off = bj * HALF;
                    const u32x4 w = *(const PG8_LAS u32x4*)(stage + (((ai * 4 + m) * 2 + bj) * 512 + tid) * 16); const f32x4 h0 = lo4(w), h1 = hi4(w);
                    if (MODE == 2) { float* o = h + roff + off; *(f32x4*)o = h0 * r * *(const f32x4*)(gf + col0 + off); *(f32x4*)(o + 4) = h1 * r * *(const f32x4*)(gf + col0 + off + 4); }
                    else { const float* cs = mrow + (size_t)(slot_shift + 1) * DM + off; const float* sh = mrow + (size_t)slot_shift * DM + off;
                        const f32x4 y0 = h0 * r * *(const f32x4*)cs + *(const f32x4*)sh, y1 = h1 * r * *(const f32x4*)(cs + 4) + *(const f32x4*)(sh + 4);
                        *(u32x4*)(A + roff + off) = pack8(y0, y1); } }
                asm volatile("" ::: "memory"); }
    }
};
template <class Epi, class Sched, bool ALIGN_EPI = false, bool SP2 = false>
__device__ __forceinline__ void gemm_phase(PG8_LAS unsigned char* lds, const Gemm g, const Sched& S, const Epi& E) {
    const int tid = threadIdx.x, wid = __builtin_amdgcn_readfirstlane(tid >> 6), lane = tid & 63, wr = wid >> 2, wc = wid & 3, fr = lane & 15, fq = lane >> 4;
    const int K = g.K;
    unsigned voffA[2], voffB[2];
#pragma unroll
    for (int i = 0; i < 2; ++i) { int R, C; stage_rc(tid * 16 + i * 8192, R, C); const int Rb = Epi::PERM ? ((R & ~31) + perm32(R & 31)) : R;
        voffA[i] = g.ta ? (unsigned)(tid * 16 + i * 8192)   : (unsigned)(R * K + C) * 2u; voffB[i] = (unsigned)(Rb * K + C) * 2u; }
    const size_t kstep = (size_t)(BK * 2);
    const size_t hstep = (size_t)HALF * K * 2;
    const size_t tstep = 2 * hstep;
    const size_t kstepA = g.ta ? (size_t)(BM * BK * 2) : kstep, hstepA = g.ta ? (size_t)(HALF * BK * 2) : hstep, tstepA = g.ta ? (size_t)BM * K * 2 : tstep;
    const unsigned ldsw = (unsigned)wid * 1024u;
    const int aoff = lds_byte(wr * 64 + fr, fq * 8), boff = lds_byte(wc * 32 + fr, fq * 8);
#define PG8_SA(b, h) (((b) * 2 + (h)) * HTB)
#define PG8_SB(b, h) ((4 + (b) * 2 + (h)) * HTB)
#define PG8_STAGE(bufoff, gbase, voff) do { _Pragma("unroll") for (int _i = 0; _i < 2; ++_i) \
        __builtin_amdgcn_global_load_lds((const unsigned*)((const char*)(gbase) + (voff)[_i]), (PG8_LAS unsigned*)(lds + (bufoff) + ldsw + _i * 8192), 16, 0, 0); } while (0)
#define PG8_LDA(dst, b, h) do { _Pragma("unroll") for (int m = 0; m < 4; ++m) _Pragma("unroll") for (int k = 0; k < 2; ++k) dst[m][k] = *(const PG8_LAS bf16x8*)(lds + PG8_SA(b, h) + aoff + m * 2048 + k * 1024); } while (0)
#define PG8_LDB(dst, b, h) do { _Pragma("unroll") for (int n = 0; n < 2; ++n) _Pragma("unroll") for (int k = 0; k < 2; ++k) dst[n][k] = *(const PG8_LAS bf16x8*)(lds + PG8_SB(b, h) + boff + n * 2048 + k * 1024); } while (0)
#define PG8_MMA(ai, bj, At, Bt) do { __builtin_amdgcn_s_setprio(1); _Pragma("unroll") for (int m = 0; m < 4; ++m) _Pragma("unroll") for (int n = 0; n < 2; ++n) _Pragma("unroll") for (int k = 0; k < 2; ++k) \
        acc[ai][bj][m][n] = __builtin_amdgcn_mfma_f32_16x16x32_bf16(Bt[n][k], At[m][k], acc[ai][bj][m][n], 0, 0, 0); __builtin_amdgcn_s_setprio(0); } while (0)
#define PG8_WAIT_V(n) asm volatile("s_waitcnt vmcnt(" #n ")" ::: "memory")
#define PG8_WAIT_L(n) asm volatile("s_waitcnt lgkmcnt(" #n ")" ::: "memory")
#define PG8_BAR __builtin_amdgcn_s_barrier()
#define PG8_SCHED __builtin_amdgcn_sched_barrier(0)
    Unit cur, nxt; int ui = 0;
    if (!S.next(0, cur)) return;
    f32x4 acc[2][2][4][2];
#pragma unroll
    for (int a = 0; a < 2; ++a)
#pragma unroll
        for (int b = 0; b < 2; ++b)
#pragma unroll
            for (int m = 0; m < 4; ++m)
#pragma unroll
                for (int n = 0; n < 2; ++n) acc[a][b][m][n] = (f32x4){0.f, 0.f, 0.f, 0.f};
    bf16x8 At[4][2], B0[2][2], B1[2][2];
    const char* cA = (const char*)g.A + (size_t)cur.pm * tstepA + (size_t)cur.kt0 * kstepA; const char* cB = (const char*)g.Bt + (size_t)cur.pn * tstep + (size_t)cur.kt0 * kstep;
    S.a_ready(cur);
    if constexpr (SP2) {
        PG8_STAGE(PG8_SB(0, 0), cB, voffB); PG8_STAGE(PG8_SB(0, 1), cB + hstep, voffB); PG8_STAGE(PG8_SA(0, 0), cA, voffA); PG8_STAGE(PG8_SA(0, 1), cA + hstepA, voffA);
        if (wr == 1) PG8_BAR;
        PG8_WAIT_V(2); PG8_BAR;
        PG8_STAGE(PG8_SB(1, 0), cB + kstep, voffB); PG8_STAGE(PG8_SA(1, 0), cA + kstepA, voffA); PG8_STAGE(PG8_SB(1, 1), cB + hstep + kstep, voffB);
        PG8_WAIT_V(6); PG8_BAR;
    } else {
        PG8_STAGE(PG8_SB(0, 0), cB, voffB); PG8_STAGE(PG8_SA(0, 0), cA, voffA); PG8_STAGE(PG8_SB(0, 1), cB + hstep, voffB); PG8_STAGE(PG8_SA(0, 1), cA + hstepA, voffA);
        if (wr == 1) PG8_BAR;
        PG8_WAIT_V(4); PG8_BAR;
        PG8_STAGE(PG8_SB(1, 0), cB + kstep, voffB); PG8_STAGE(PG8_SA(1, 0), cA + kstepA, voffA); PG8_STAGE(PG8_SB(1, 1), cB + hstep + kstep, voffB);
        PG8_WAIT_V(6); PG8_BAR;
    }
    for (;;) {
        const bool has_next = S.next(ui + 1, nxt);
        const char* nA = has_next ? (const char*)g.A + (size_t)nxt.pm * tstepA + (size_t)nxt.kt0 * kstepA : cA; const char* nB = has_next ? (const char*)g.Bt + (size_t)nxt.pn * tstep + (size_t)nxt.kt0 * kstep : cB;
        const int nt = cur.nkt;
        for (int t = 0; t < nt; t += 2) {
            const bool last = (t == nt - 2);
            const char* a1 = cA + (size_t)(t + 1) * kstepA;
            const char* a2 = last ? nA : cA + (size_t)(t + 2) * kstepA; const char* b2 = last ? nB : cB + (size_t)(t + 2) * kstep;
            const char* a3 = a2 + kstepA; const char* b3 = b2 + kstep;
            if (last && has_next) S.a_ready(nxt);
            if constexpr (SP2) {
            PG8_LDB(B0, 0, 0); PG8_LDB(B1, 0, 1); PG8_SCHED; PG8_LDA(At, 0, 0); PG8_STAGE(PG8_SA(1, 1), a1 + hstepA, voffA);
            PG8_WAIT_V(8); PG8_WAIT_L(0); PG8_BAR; PG8_MMA(0, 0, At, B0); PG8_MMA(0, 1, At, B1); PG8_BAR; PG8_SCHED;
            PG8_LDA(At, 0, 1); PG8_STAGE(PG8_SB(0, 0), b2, voffB); PG8_STAGE(PG8_SB(0, 1), b2 + hstep, voffB); PG8_STAGE(PG8_SA(0, 0), a2, voffA);
            PG8_WAIT_V(8); PG8_WAIT_L(0); PG8_BAR; PG8_MMA(1, 0, At, B0); PG8_MMA(1, 1, At, B1); PG8_BAR; PG8_SCHED;
            PG8_LDB(B0, 1, 0); PG8_LDB(B1, 1, 1); PG8_SCHED; PG8_LDA(At, 1, 0); PG8_STAGE(PG8_SA(0, 1), a2 + hstepA, voffA);
            PG8_WAIT_V(8); PG8_WAIT_L(0); PG8_BAR; PG8_MMA(0, 0, At, B0); PG8_MMA(0, 1, At, B1); PG8_BAR; PG8_SCHED;
            PG8_LDA(At, 1, 1); PG8_STAGE(PG8_SB(1, 0), b3, voffB); PG8_STAGE(PG8_SB(1, 1), b3 + hstep, voffB); PG8_STAGE(PG8_SA(1, 0), a3, voffA);
            PG8_WAIT_V(8); PG8_WAIT_L(0); PG8_BAR; PG8_MMA(1, 0, At, B0); PG8_MMA(1, 1, At, B1); PG8_BAR; PG8_SCHED;
            } else {
            PG8_LDB(B0, 0, 0); PG8_SCHED; PG8_LDA(At, 0, 0); PG8_STAGE(PG8_SA(1, 1), a1 + hstepA, voffA);
            PG8_WAIT_L(8); PG8_BAR; PG8_WAIT_L(0); PG8_MMA(0, 0, At, B0); PG8_BAR; PG8_SCHED;
            PG8_LDB(B1, 0, 1); PG8_STAGE(PG8_SB(0, 0), b2, voffB);
            PG8_BAR; PG8_WAIT_L(0); PG8_MMA(0, 1, At, B1); PG8_BAR;
            PG8_LDA(At, 0, 1); PG8_STAGE(PG8_SA(0, 0), a2, voffA);
            PG8_BAR; PG8_WAIT_L(0); PG8_MMA(1, 0, At, B0); PG8_BAR; PG8_SCHED;
            PG8_STAGE(PG8_SB(0, 1), b2 + hstep, voffB);
            PG8_WAIT_V(6); PG8_BAR; PG8_MMA(1, 1, At, B1); PG8_BAR;
            PG8_LDB(B0, 1, 0); PG8_SCHED; PG8_LDA(At, 1, 0); PG8_STAGE(PG8_SA(0, 1), a2 + hstepA, voffA);
            PG8_WAIT_L(8); PG8_BAR; PG8_WAIT_L(0); PG8_MMA(0, 0, At, B0); PG8_BAR; PG8_SCHED;
            PG8_LDB(B1, 1, 1); PG8_STAGE(PG8_SB(1, 0), b3, voffB);
            PG8_BAR; PG8_WAIT_L(0); PG8_MMA(0, 1, At, B1); PG8_BAR;
            PG8_LDA(At, 1, 1); PG8_STAGE(PG8_SA(1, 0), a3, voffA);
            PG8_BAR; PG8_WAIT_L(0); PG8_MMA(1, 0, At, B0); PG8_BAR; PG8_SCHED;
            PG8_STAGE(PG8_SB(1, 1), b3 + hstep, voffB);
            PG8_WAIT_V(6); PG8_BAR; PG8_MMA(1, 1, At, B1); PG8_BAR;
            }
        }
        if constexpr (ALIGN_EPI) { if (wr == 0) PG8_BAR; }
        if constexpr (!Epi::AFTER_DRAIN) { E(acc, cur, wr, wc, fr, fq); S.done(cur); } else { if (has_next) { E(acc, cur, wr, wc, fr, fq); S.done(cur); } }
        if (!has_next) break;
#pragma unroll
        for (int a = 0; a < 2; ++a)
#pragma unroll
            for (int b = 0; b < 2; ++b)
#pragma unroll
                for (int m = 0; m < 4; ++m)
#pragma unroll
                    for (int n = 0; n < 2; ++n) acc[a][b][m][n] = (f32x4){0.f, 0.f, 0.f, 0.f};
        cur = nxt; cA = nA; cB = nB; ++ui;
        if constexpr (ALIGN_EPI) { if (wr == 1) PG8_BAR; }
    }
    PG8_WAIT_V(0);
    if constexpr (!ALIGN_EPI) { if (wr == 0) PG8_BAR; }
    PG8_BAR;
    if constexpr (Epi::AFTER_DRAIN) { E.fused(acc, cur, wr, wc, fr, fq, lds, wid, lane); S.done(cur); }
#undef PG8_SA
#undef PG8_SB
#undef PG8_STAGE
#undef PG8_LDA
#undef PG8_LDB
#undef PG8_MMA
#undef PG8_WAIT_V
#undef PG8_WAIT_L
#undef PG8_BAR
#undef PG8_SCHED
}
}

#ifndef PROBE_DUP
#define PROBE_DUP 0
#endif
#ifndef PROBE_T
#define PROBE_T -1
#endif
#define PROBE_AMP 4
#ifndef MK_MULTI_LAUNCH
#define MK_MULTI_LAUNCH 0
#endif
#define LAS __attribute__((address_space(3)))
typedef unsigned short bf16;
typedef float f32x4 __attribute__((ext_vector_type(4)));
typedef unsigned v4u __attribute__((ext_vector_type(4)));
typedef unsigned v2u __attribute__((ext_vector_type(2)));
typedef short bf16x8 __attribute__((ext_vector_type(8)));

constexpr int D = 1024, NP = 16384  , NS = 1024  , M = NP + NS, SEQ = 2048, DSEQ = 8, NBP = 8, NBS = 128, NB = NBP + NBS;
constexpr int FF = 2816, DC = 512, DP = 512, CW = 31, PM = 16, NMOD = 9, MODN = NMOD * D;
constexpr float EPS = 1e-6f;
constexpr size_t O_Y = 0, O_NSCP = (size_t)M * D, O_NSPP = O_NSCP + (size_t)NBP * 30 * DC, O_NSCS = O_NSPP + (size_t)NBP * 15 * DP, O_NSPS = O_NSCS + (size_t)NBS * 30 * DC;
constexpr size_t MiB = 1u << 20;
constexpr size_t WS_CNT = 16384;
constexpr size_t WS_XBUF = 128 * 1024;
constexpr size_t CTL_ZERO = 128 * 1024;
constexpr size_t WS_MOD = 1 * MiB;
constexpr size_t WS_WUP1 = 6 * MiB;
constexpr size_t WS_WDN1 = 17 * MiB;
constexpr size_t WS_WIN = 23 * MiB;
constexpr size_t WS_WOUT = 26 * MiB;
constexpr size_t WS_WUP2 = 28 * MiB;
constexpr size_t WS_WDN2 = 39 * MiB;
constexpr size_t WS_SC = 45 * MiB;
constexpr size_t WS_HB = 46 * MiB;
constexpr size_t WS_A = 80 * MiB;
constexpr size_t WS_ACT = 114 * MiB;
constexpr size_t WS_PART = 208 * MiB;
constexpr size_t WS_END = 252 * MiB;
constexpr int LDS_BYTES = 147456;
constexpr int XCH_LDS_OFF = 131072 + 1024;
constexpr int BAR_LDS_OFF = 131072 + 256;

__device__ __forceinline__ unsigned pk2(float lo, float hi) { unsigned r; asm("v_cvt_pk_bf16_f32 %0, %1, %2" : "=v"(r) : "v"(lo), "v"(hi)); return r; }
__device__ __forceinline__ unsigned f2bf(float f) { return pk2(f, f) & 0xffffu; }
__device__ __forceinline__ float bf2f(bf16 b) { return __builtin_bit_cast(float, (unsigned)b << 16); }
__device__ __forceinline__ float wave_sum(float v) {
#pragma unroll
    for (int o = 1; o < 64; o <<= 1) v += __shfl_xor(v, o);
    return v;
}
#define LDS_WAIT() asm volatile("s_waitcnt lgkmcnt(0)" ::: "memory")
#define XB_TMO      128
#define XB_XCNT(j)  (256  + 64 * (j))
#define XB_XSUB(j)  (1280 + 64 * (j))
#define XB_XGEN(j)  (2304 + 64 * (j))
#define XB_TOP      3328
#define XB_TOPGEN   3392
#define XCD_BAR_WORDS 3456
#define XB_SPIN_CAP (1u << 18)

__device__ __forceinline__ unsigned xb_ld(unsigned* p)              { return __hip_atomic_load(p, __ATOMIC_RELAXED, __HIP_MEMORY_SCOPE_AGENT); }
__device__ __forceinline__ unsigned xb_add(unsigned* p, unsigned v) { return __hip_atomic_fetch_add(p, v, __ATOMIC_RELAXED, __HIP_MEMORY_SCOPE_AGENT); }
__device__ __forceinline__ unsigned xb_xcc_id() { return (unsigned)__builtin_amdgcn_s_getreg((3 << 11) | 20) & 0xFu; }
#define XB_SPIN(cond, bar) do { unsigned _sp = 0; while (cond) { __builtin_amdgcn_s_sleep(1); \
    if ((++_sp & 255u) == 0u) { if (xb_ld(&(bar)[XB_TMO])) break; if (_sp > XB_SPIN_CAP) { atomicAdd(&(bar)[XB_TMO], 1u); break; } } } } while (0)

struct XcdBarrier {
    unsigned* bar; unsigned x;
    volatile LAS unsigned* st;
};

__device__ __forceinline__ XcdBarrier xcd_barrier_post(unsigned* bar, volatile LAS unsigned* st) {
    XcdBarrier b; b.bar = bar; b.x = xb_xcc_id(); b.st = st;
    if (threadIdx.x == 0) (void)xb_add(&bar[XB_XCNT(b.x)], 1u);
    return b;
}
__device__ __forceinline__ void xcd_barrier_complete(unsigned* bar, unsigned x, unsigned& nloc, unsigned& nx) {
    const unsigned G = gridDim.x * gridDim.y * gridDim.z;
    unsigned sum, cnt, mine, sp = 0u;
    for (;;) {
        sum = 0u; cnt = 0u; mine = 0u;
#pragma unroll
        for (unsigned j = 0; j < 16; ++j) { const unsigned c = xb_ld(&bar[XB_XCNT(j)]); sum += c; cnt += (c > 0u) ? 1u : 0u; mine = (j == x) ? c : mine; }
        if (sum == G) break;
        __builtin_amdgcn_s_sleep(1);
        if ((++sp & 255u) == 0u) { if (xb_ld(&bar[XB_TMO])) break; if (sp > XB_SPIN_CAP) { atomicAdd(&bar[XB_TMO], 1u); break; } }
    }
    nloc = mine > 0u ? mine : 1u; nx = cnt > 0u ? cnt : 1u;
}

__device__ __forceinline__ void xcd_barrier(const XcdBarrier& b) {
    asm volatile("s_waitcnt vmcnt(0)" ::: "memory");
    __syncthreads();
    if (threadIdx.x == 0) {
        unsigned* bar = b.bar;
        __builtin_amdgcn_s_waitcnt(0);
        unsigned nloc = b.st[0], nx = b.st[1];
        if (nloc == 0u) { xcd_barrier_complete(bar, b.x, nloc, nx); b.st[0] = nloc; b.st[1] = nx; }
        const unsigned old = xb_add(&bar[XB_XSUB(b.x)], 1u);
        const unsigned gen = old / nloc;
        if (old + 1u == (gen + 1u) * nloc) {
            __builtin_amdgcn_fence(__ATOMIC_RELEASE, "agent");
            asm volatile("s_waitcnt vmcnt(0)" ::: "memory");
            const unsigned og = xb_add(&bar[XB_TOP], 1u);
            const unsigned tg = og / nx;
            if (og + 1u == (tg + 1u) * nx) xb_add(&bar[XB_TOPGEN], 1u);
            else XB_SPIN(xb_ld(&bar[XB_TOPGEN]) == tg, bar);
            __builtin_amdgcn_fence(__ATOMIC_ACQUIRE, "agent");
            xb_add(&bar[XB_XGEN(b.x)], 1u);
            asm volatile("s_waitcnt vmcnt(0)" ::: "memory");
        } else {
            XB_SPIN(xb_ld(&bar[XB_XGEN(b.x)]) == gen, bar);
            __builtin_amdgcn_fence(__ATOMIC_ACQUIRE, "agent");
            asm volatile("s_waitcnt vmcnt(0)" ::: "memory");
        }
    }
    __syncthreads();
}

struct Args { const float* in[24]; float* out; unsigned char* ws; int ph_lo, ph_hi; };
enum { I_XP = 0, I_XS, I_SCONV, I_SPOOL, I_CP, I_CS, I_WADA, I_BADA, I_G1, I_WUP1, I_WDN1, I_GM, I_WIN, I_WDW, I_BDW, I_LNG, I_LNB, I_WPOOL, I_PSCALE, I_WOUT, I_G2, I_WUP2, I_WDN2, I_GF };

struct TrItem { const float* src; bf16* dst; int ldw, ldt; };
__device__ __forceinline__ void tr_load(const TrItem& t, int lane, f32x4 (&v)[8]) {
    const float* p = t.src + (size_t)(lane >> 3) * t.ldw + (lane & 7) * 4;
#pragma unroll
    for (int i = 0; i < 8; ++i) v[i] = __builtin_nontemporal_load((const f32x4*)(p + (size_t)(8 * i) * t.ldw));
}
__device__ __forceinline__ void tr_to_lds(const f32x4 (&v)[8], LAS float* scr, int lane) {
#pragma unroll
    for (int i = 0; i < 8; ++i) { LAS float* d = scr + (8 * i + (lane >> 3)) * 33 + (lane & 7) * 4; d[0] = v[i].x; d[1] = v[i].y; d[2] = v[i].z; d[3] = v[i].w; }
    LDS_WAIT(); asm volatile("" ::: "memory");
}
__device__ __forceinline__ void tr_store(const TrItem& t, LAS float* scr, int lane) {
    const int c = lane & 7;
#pragma unroll
    for (int j = 0; j < 4; ++j) { const int n = (lane >> 3) + 8 * j; const LAS float* s = scr + (8 * c) * 33 + n;
        v4u o; o.x = pk2(s[0 * 33], s[1 * 33]); o.y = pk2(s[2 * 33], s[3 * 33]); o.z = pk2(s[4 * 33], s[5 * 33]); o.w = pk2(s[6 * 33], s[7 * 33]);
        *(v4u*)(t.dst + (size_t)n * t.ldt + 8 * c) = o; }
    LDS_WAIT(); asm volatile("" ::: "memory");
}
__device__ __forceinline__ int pair_row(int n, int half) { const int sec = n >= half ? 1 : 0, j = n - sec * half; return (j >> 7) * 256 + sec * 128 + (j & 127); }
constexpr int TR_I_UP = (D / 64) * (2 * FF / 32), TR_I_DN = (FF / 64) * (D / 32), TR_I_IN = (D / 64) * (1536 / 32), TR_I_OUT = (512 / 64) * (D / 32), TR_NITEMS = 2 * TR_I_UP + 2 * TR_I_DN + TR_I_IN + TR_I_OUT;
__device__ __forceinline__ TrItem tr_decode(const Args& a, int it) {
    unsigned char* ws = a.ws; int r = it; TrItem t;
    if (r < 2 * TR_I_UP) { const int l = r >= TR_I_UP; r -= l * TR_I_UP; const int nblk = 2 * FF / 32, kb = r / nblk, nb = r % nblk;
        t.ldw = 2 * FF; t.ldt = D; t.src = a.in[l ? I_WUP2 : I_WUP1] + (size_t)(kb * 64) * t.ldw + nb * 32; t.dst = (bf16*)(ws + (l ? WS_WUP2 : WS_WUP1)) + (size_t)pair_row(nb * 32, FF) * D + kb * 64; return t; }
    r -= 2 * TR_I_UP;
    if (r < 2 * TR_I_DN) { const int l = r >= TR_I_DN; r -= l * TR_I_DN; const int nblk = D / 32, kb = r / nblk, nb = r % nblk;
        t.ldw = D; t.ldt = FF; t.src = a.in[l ? I_WDN2 : I_WDN1] + (size_t)(kb * 64) * t.ldw + nb * 32; t.dst = (bf16*)(ws + (l ? WS_WDN2 : WS_WDN1)) + (size_t)(nb * 32) * FF + kb * 64; return t; }
    r -= 2 * TR_I_DN;
    if (r < TR_I_IN) { const int nblk = 1536 / 32, kb = r / nblk, nb = r % nblk, n0 = nb * 32;
        t.ldw = 1536; t.ldt = D; t.src = a.in[I_WIN] + (size_t)(kb * 64) * t.ldw + n0; t.dst = (bf16*)(ws + WS_WIN) + (size_t)(n0 < 1024 ? pair_row(n0, 512) : n0) * D + kb * 64; return t; }
    r -= TR_I_IN;
    { const int nblk = D / 32, kb = r / nblk, nb = r % nblk;
        t.ldw = D; t.ldt = D; t.src = a.in[I_WOUT] + (size_t)(kb * 64) * t.ldw + nb * 32; t.dst = (bf16*)(ws + WS_WOUT) + (size_t)(nb * 32) * D + kb * 64; return t; }
}

__device__ __forceinline__ void convert_items(const Args& a, LAS unsigned char* lds, int lo, int hi, int iw, int NIW) {
    const int lane = threadIdx.x & 63, wave = __builtin_amdgcn_readfirstlane(threadIdx.x >> 6);
    LAS float* scr = (LAS float*)(lds + wave * 16384);
    f32x4 v[8]; int it = lo + iw;
    if (it < hi) tr_load(tr_decode(a, it), lane, v);
    for (; it < hi; it += NIW) {
        tr_to_lds(v, scr, lane);
        if (it + NIW < hi) tr_load(tr_decode(a, it + NIW), lane, v);
        tr_store(tr_decode(a, it), scr, lane);
    }
}
__device__ __forceinline__ void p0_prologue(const Args& a, LAS unsigned char* lds, int G) {
    const int tid = threadIdx.x, lane = tid & 63, wave = __builtin_amdgcn_readfirstlane(tid >> 6);
    unsigned char* ws = a.ws;
    LAS float* scr = (LAS float*)(lds + wave * 16384);
    const int gw = blockIdx.x * 8 + wave, NGW = G * 8;
    if (G == 256) { convert_items(a, lds, 0, TR_I_UP, gw, NGW); convert_items(a, lds, 2 * TR_I_UP + 2 * TR_I_DN, TR_NITEMS, gw, NGW); }
    else convert_items(a, lds, 0, TR_NITEMS, gw, NGW);
    const int gt = blockIdx.x * 512 + tid, NGT = G * 512;
    for (int i = gt; i < 144 * D / 4; i += NGT) { const int row = i / (D / 4), c4 = i % (D / 4);
        f32x4 v = (f32x4){0.f, 0.f, 0.f, 0.f};
        if (row < NBP) v = *(const f32x4*)(a.in[I_CP] + (size_t)row * D + c4 * 4); else if (row < NB) v = *(const f32x4*)(a.in[I_CS] + (size_t)(row - NBP) * D + c4 * 4);
        v2u o; o.x = pk2(v[0] * pg8::sigmoid_f(v[0]), v[1] * pg8::sigmoid_f(v[1])); o.y = pk2(v[2] * pg8::sigmoid_f(v[2]), v[3] * pg8::sigmoid_f(v[3]));
        *(v2u*)((bf16*)(ws + WS_SC) + (size_t)row * D + c4 * 4) = o; }
    __syncthreads();
    {   LAS float* wpl = (LAS float*)lds;
        LAS float* wol = (LAS float*)(lds + 128 * 129 * 4);
        for (int item = blockIdx.x; item < 4 * 64; item += G) { const int g = item >> 6, n0 = (item & 63) * 16;
            const float* wp = a.in[I_WPOOL] + (size_t)g * 128 * 128;
#pragma unroll
            for (int k = 0; k < 8; ++k) { const int q = tid + 512 * k, c = q >> 5, d4 = (q & 31) * 4; const f32x4 v = *(const f32x4*)(wp + c * 128 + d4);
                LAS float* dd = wpl + c * 129 + d4; dd[0] = v.x; dd[1] = v.y; dd[2] = v.z; dd[3] = v.w; }
            { const int d = tid >> 2, n4 = (tid & 3) * 4; const f32x4 v = *(const f32x4*)(a.in[I_WOUT] + (size_t)(512 + 128 * g + d) * D + n0 + n4) * a.in[I_PSCALE][128 * g + d];
                *(LAS f32x4*)(wol + d * 16 + n4) = v; }
            LDS_WAIT(); __syncthreads();
            const int n = tid & 15, cb = (tid >> 4) * 4;
            float acc[4] = {0.f, 0.f, 0.f, 0.f};
#pragma unroll 8
            for (int d = 0; d < 128; ++d) { const float w = wol[d * 16 + n];
#pragma unroll
                for (int i2 = 0; i2 < 4; ++i2) acc[i2] = __builtin_fmaf(wpl[(cb + i2) * 129 + d], w, acc[i2]); }
            v2u o; o.x = pk2(acc[0], acc[1]); o.y = pk2(acc[2], acc[3]);
            *(v2u*)((bf16*)(ws + WS_WOUT) + (size_t)(n0 + n) * D + 512 + 128 * g + cb) = o;
            LDS_WAIT(); __syncthreads();
        } }
}

__device__ __forceinline__ unsigned silu_pk(float x, float y) { return pk2(x * pg8::sigmoid_f(x), y * pg8::sigmoid_f(y)); }
__device__ __forceinline__ void mod_phase(const Args& a, LAS unsigned char* lds, int G) {
    const int tid = threadIdx.x, lane = tid & 63, wave = __builtin_amdgcn_readfirstlane(tid >> 6), fr = lane & 15, fq = lane >> 4;
    float* mod = (float*)(a.ws + WS_MOD); const bf16* SC = (const bf16*)(a.ws + WS_SC);
    const float* W = a.in[I_WADA];
    for (int it = blockIdx.x; it < MODN / 48; it += G) { const int ng = (G % 8 == 0 && G >= 192) ? (it % 8) * 24 + it / 8 : it;
        f32x4 acc[3][9];
#pragma unroll
        for (int t = 0; t < 3; ++t)
#pragma unroll
            for (int i = 0; i < 9; ++i) acc[t][i] = (f32x4){0.f, 0.f, 0.f, 0.f};
#pragma unroll 1
        for (int kp = 0; kp < 2; ++kp) {
            float x[2][3][8]; bf16x8 sf[9];
#pragma unroll
            for (int h = 0; h < 2; ++h) { const int k0 = wave * 128 + (2 * kp + h) * 32 + fq * 8;
#pragma unroll
                for (int t = 0; t < 3; ++t) { const float* wp = W + (size_t)k0 * MODN + ng * 48 + t * 16 + fr;
#pragma unroll
                    for (int j2 = 0; j2 < 8; ++j2) x[h][t][j2] = __builtin_nontemporal_load(wp + (size_t)j2 * MODN); } }
#pragma unroll
            for (int h = 0; h < 2; ++h) { const int k0 = wave * 128 + (2 * kp + h) * 32 + fq * 8;
#pragma unroll
                for (int i = 0; i < 9; ++i) sf[i] = *(const bf16x8*)(SC + (size_t)(16 * i + fr) * D + k0);
                asm volatile("" ::: "memory"); __builtin_amdgcn_sched_barrier(0);
                bf16x8 wf[3];
#pragma unroll
                for (int t = 0; t < 3; ++t) { v4u o; o.x = pk2(x[h][t][0], x[h][t][1]); o.y = pk2(x[h][t][2], x[h][t][3]); o.z = pk2(x[h][t][4], x[h][t][5]); o.w = pk2(x[h][t][6], x[h][t][7]); wf[t] = __builtin_bit_cast(bf16x8, o); }
#pragma unroll
                for (int i = 0; i < 9; ++i)
#pragma unroll
                    for (int t = 0; t < 3; ++t) acc[t][i] = __builtin_amdgcn_mfma_f32_16x16x32_bf16(wf[t], sf[i], acc[t][i], 0, 0, 0);
                asm volatile("" ::: "memory"); __builtin_amdgcn_sched_barrier(0); }
        }
#pragma unroll
        for (int step = 4; step >= 1; step >>= 1) {
            if (wave >= step && wave < 2 * step) { LAS f32x4* sl = (LAS f32x4*)(lds + (wave - step) * 27648) + lane;
#pragma unroll
                for (int t = 0; t < 3; ++t)
#pragma unroll
                    for (int i = 0; i < 9; ++i) sl[(t * 9 + i) * 64] = acc[t][i]; }
            LDS_WAIT(); __syncthreads();
            if (wave < step) { const LAS f32x4* sl = (const LAS f32x4*)(lds + wave * 27648) + lane;
#pragma unroll
                for (int t = 0; t < 3; ++t)
#pragma unroll
                    for (int i = 0; i < 9; ++i) acc[t][i] += sl[(t * 9 + i) * 64]; }
            LDS_WAIT(); __syncthreads();
        }
        if (wave == 0) {
#pragma unroll
            for (int t = 0; t < 3; ++t) { const int n = ng * 48 + t * 16 + 4 * fq, slot = n >> 10, col = n & 1023, kind = slot % 3;
                const f32x4 bias = *(const f32x4*)(a.in[I_BADA] + n);
                f32x4 gv = (f32x4){1.f, 1.f, 1.f, 1.f};
                if (kind == 1) gv = *(const f32x4*)(a.in[slot == 1 ? I_G1 : (slot == 4 ? I_GM : I_G2)] + col);
                const float gs = (slot == 2 || slot == 8) ? 0.5f : 1.0f;
#pragma unroll
                for (int i = 0; i < 9; ++i) { const int b = 16 * i + fr; f32x4 v = acc[t][i] + bias;
                    if (kind == 1) v = gv * (v + 1.0f); else if (kind == 2) v = v * gs;
                    if (b < NB) *(f32x4*)(mod + (size_t)b * MODN + n) = v; } }
        }
    }
}

__device__ __forceinline__ void norm1_phase(const Args& a, int G) {
    const int tid = threadIdx.x, lane = tid & 63, wave = __builtin_amdgcn_readfirstlane(tid >> 6);
    const float* mod = (const float*)(a.ws + WS_MOD); bf16* A = (bf16*)(a.ws + WS_A);
    const int gw = blockIdx.x * 8 + wave, NGW = G * 8;
    for (int row = gw; row < M; row += NGW) {
        const f32x4* xr = (const f32x4*)(row < NP ? a.in[I_XP] + (size_t)row * D : a.in[I_XS] + (size_t)(row - NP) * D) + 2 * lane;
        f32x4 v[4]; float s = 0.f;
#pragma unroll
        for (int j = 0; j < 4; ++j) v[j] = __builtin_nontemporal_load(xr + (j >> 1) * 128 + (j & 1));
#pragma unroll
        for (int j = 0; j < 4; ++j) s += (v[j].x * v[j].x + v[j].y * v[j].y) + (v[j].z * v[j].z + v[j].w * v[j].w);
        const float r = 1.0f / sqrtf(wave_sum(s) * (1.0f / D) + EPS);
        const float* mrow = mod + (size_t)pg8::mod_row(row) * MODN;
        const f32x4* sh = (const f32x4*)mrow + 2 * lane; const f32x4* cs = (const f32x4*)(mrow + D) + 2 * lane;
        v4u* o16 = (v4u*)(A + (size_t)row * D) + lane;
#pragma unroll
        for (int jp = 0; jp < 2; ++jp) { const f32x4 y0 = v[2 * jp] * r * cs[jp * 128] + sh[jp * 128], y1 = v[2 * jp + 1] * r * cs[jp * 128 + 1] + sh[jp * 128 + 1];
            v4u o; o.x = pk2(y0.x, y0.y); o.y = pk2(y0.z, y0.w); o.z = pk2(y1.x, y1.y); o.w = pk2(y1.z, y1.w); o16[64 * jp] = o; }
    }
}

template <int NPARTS, bool BASE_X, bool FINAL> __device__ __forceinline__ void sample_norm_phase(const Args& a, LAS unsigned char* lds, int G, int slot_shift, int slot_gate) {
    const int tid = threadIdx.x, lane = tid & 63, wave = __builtin_amdgcn_readfirstlane(tid >> 6), rq = wave & 3, half = wave >> 2;
    const float* mod = (const float*)(a.ws + WS_MOD); bf16* A = (bf16*)(a.ws + WS_A); const float* part = (const float*)(a.ws + WS_PART); bf16* HB = (bf16*)(a.ws + WS_HB);
    LAS float* ss = (LAS float*)lds;
    for (int rb = blockIdx.x; rb < NS / 4; rb += G) {
        const int rs = rb * 4 + rq, row = NP + rs;
        f32x4* yrow = (f32x4*)(a.out + (size_t)row * D) + lane + 128 * half;
        v2u* hbrow = (v2u*)(HB + (size_t)row * D) + lane + 128 * half;
        const f32x4* xrow = (const f32x4*)(a.in[I_XS] + (size_t)rs * D) + lane + 128 * half;
        const float* mr = mod + (size_t)(NBP + (rs >> 3)) * MODN;
        const f32x4* gt = (const f32x4*)(mr + (size_t)slot_gate * D) + lane + 128 * half;
        const v2u* pr = (const v2u*)((const bf16*)part + (size_t)rs * D) + lane + 128 * half;
        f32x4 v[2]; float s = 0.f;
#pragma unroll
        for (int j = 0; j < 2; ++j) { f32x4 acc = (f32x4){0.f, 0.f, 0.f, 0.f};
#pragma unroll
            for (int p = 0; p < NPARTS; ++p) { const v2u q = pr[(size_t)p * (1024 * D / 4) + 64 * j]; acc += (f32x4){bf2f((bf16)(q.x & 0xffffu)), bf2f((bf16)(q.x >> 16)), bf2f((bf16)(q.y & 0xffffu)), bf2f((bf16)(q.y >> 16))}; }
            f32x4 bv; if (BASE_X) bv = xrow[64 * j]; else { const v2u q = hbrow[64 * j]; bv = (f32x4){bf2f((bf16)(q.x & 0xffffu)), bf2f((bf16)(q.x >> 16)), bf2f((bf16)(q.y & 0xffffu)), bf2f((bf16)(q.y >> 16))}; }
            v[j] = bv + gt[64 * j] * acc;
            { v2u w; w.x = pk2(v[j].x, v[j].y); w.y = pk2(v[j].z, v[j].w); if (!FINAL) hbrow[64 * j] = w;
              v[j] = (f32x4){bf2f((bf16)(w.x & 0xffffu)), bf2f((bf16)(w.x >> 16)), bf2f((bf16)(w.y & 0xffffu)), bf2f((bf16)(w.y >> 16))}; }
            s += (v[j].x * v[j].x + v[j].y * v[j].y) + (v[j].z * v[j].z + v[j].w * v[j].w); }
        s = wave_sum(s);
        if (lane == 0) ss[wave] = s;
        LDS_WAIT(); __syncthreads();
        const float r = 1.0f / sqrtf((ss[rq] + ss[rq + 4]) * (1.0f / D) + EPS);
        if (FINAL) { const f32x4* gf = (const f32x4*)a.in[I_GF] + lane + 128 * half;
#pragma unroll
            for (int j = 0; j < 2; ++j) yrow[64 * j] = v[j] * r * gf[64 * j];
        } else { const f32x4* sh = (const f32x4*)(mr + (size_t)slot_shift * D) + lane + 128 * half; const f32x4* cs = (const f32x4*)(mr + (size_t)(slot_shift + 1) * D) + lane + 128 * half;
            v2u* o8 = (v2u*)(A + (size_t)row * D) + lane + 128 * half;
#pragma unroll
            for (int j = 0; j < 2; ++j) { const f32x4 y = v[j] * r * cs[64 * j] + sh[64 * j]; v2u o; o.x = pk2(y.x, y.y); o.y = pk2(y.z, y.w); o8[64 * j] = o; } }
        LDS_WAIT(); __syncthreads();
    }
}

constexpr int MIX_CONV_ROWS = 46, MIX_POOL_ROWS = 31, MIX_POOL_OFF = MIX_CONV_ROWS * 1024, MIX_V_OFF = MIX_POOL_OFF + MIX_POOL_ROWS * 1024, MIX_NU = NS / 16 + NP / 16;
#define MIX_DECODE(u_, prompt_, b_, t0_, row0_) const bool prompt_ = (u_) >= NS / 16; const int b_ = prompt_ ? ((u_) - NS / 16) / (SEQ / 16) : (u_) * 2, t0_ = prompt_ ? (((u_) - NS / 16) % (SEQ / 16)) * 16 : 0, row0_ = prompt_ ? b_ * SEQ + t0_ : NP + (u_) * 16
#define MIX_LOAD(u_) do { MIX_DECODE(u_, p_, bb_, tt0_, r0_); (void)p_; (void)bb_; (void)tt0_; \
        _Pragma("unroll") for (int k = 0; k < 6; ++k) { const int q = tid + 512 * k; if (q < MIX_CONV_ROWS * 64) pc[k] = *(const v4u*)(U + (long)(r0_ - 30 + (q >> 6)) * D + (q & 63) * 8); } \
        _Pragma("unroll") for (int k = 0; k < 4; ++k) { const int q = tid + 512 * k; if (q < MIX_POOL_ROWS * 64) pp[k] = *(const v4u*)(U + (long)(r0_ - 15 + (q >> 6)) * D + DC + (q & 63) * 8); } } while (0)
__device__ __forceinline__ void mixer_phase(const Args& a, LAS unsigned char* lds, int G) {
    const int tid = threadIdx.x, lane = tid & 63, wave = __builtin_amdgcn_readfirstlane(tid >> 6), c = tid;
    const bf16* U = (const bf16*)(a.ws + WS_ACT); bf16* A = (bf16*)(a.ws + WS_A);
    LAS bf16* convT = (LAS bf16*)lds; LAS bf16* poolT = (LAS bf16*)(lds + MIX_POOL_OFF); LAS float* vbuf = (LAS float*)(lds + MIX_V_OFF);
    typedef float f32x2m __attribute__((ext_vector_type(2)));
#define MIX_UNPK(w_) ((f32x2m){__builtin_bit_cast(float, (w_) << 16), __builtin_bit_cast(float, (w_) & 0xffff0000u)})
    const int grp = wave >> 2, c2 = 2 * (tid & 255);
    f32x2m wdw[CW];
#pragma unroll
    for (int k = 0; k < CW; ++k) wdw[k] = *(const f32x2m*)(a.in[I_WDW] + k * DC + c2);
    const f32x2m bdw = *(const f32x2m*)(a.in[I_BDW] + c2);
    const int gi = c2 >> 7, win = 2 << gi; const float inv_win = 1.0f / (float)win;
    v4u pc[6], pp[4];
    LAS bf16* pbuf = (LAS bf16*)(lds + MIX_V_OFF + 16 * DC * 4);
    const bool split_tail = (G == 256);
    const int bx = (int)blockIdx.x, nit = split_tail ? (bx < 128 ? 5 : 4) : (bx < MIX_NU ? (MIX_NU - bx + G - 1) / G : 0);
#define MIX_UNIT(i_) (split_tail ? ((i_) < 4 ? bx + 256 * (i_) : 1024 + (bx & 63)) : bx + G * (i_))
    if (nit > 0) MIX_LOAD(MIX_UNIT(0));
    for (int iter = 0; iter < nit; ++iter) { const int uidx = MIX_UNIT(iter);
        const int g_lo = (split_tail && iter == 4 && bx >= 64) ? 1 : 0, g_hi = (split_tail && iter == 4 && bx < 64) ? 1 : 2;
#pragma unroll
        for (int k = 0; k < 6; ++k) { const int q = tid + 512 * k; if (q < MIX_CONV_ROWS * 64) *(LAS v4u*)(convT + (q >> 6) * 512 + (q & 63) * 8) = pc[k]; }
#pragma unroll
        for (int k = 0; k < 4; ++k) { const int q = tid + 512 * k; if (q < MIX_POOL_ROWS * 64) *(LAS v4u*)(poolT + (q >> 6) * 512 + (q & 63) * 8) = pp[k]; }
        LDS_WAIT(); __syncthreads();
        if (iter + 1 < nit) MIX_LOAD(MIX_UNIT(iter + 1));
        MIX_DECODE(uidx, prompt, b0, t0, row0);
        if (grp >= g_lo && grp < g_hi) { const int g = grp;
            const int tb = t0 + g * 8, b = prompt ? b0 : b0 + g;
            const f32x2m zero2 = (f32x2m){0.f, 0.f};
            f32x2m in[38];
            { const LAS unsigned* tp = (const LAS unsigned*)(convT + (g * 8) * 512 + c2);
                if (prompt) {
                    if (tb >= 30) {
#pragma unroll
                        for (int i = 0; i < 38; ++i) { const unsigned w = tp[i * 256]; in[i] = MIX_UNPK(w); }
                    } else {
#pragma unroll
                        for (int i = 0; i < 38; ++i) { const unsigned w = tp[i * 256]; in[i] = (tb - 30 + i >= 0) ? MIX_UNPK(w) : zero2; }
                    }
                } else {
                    const float* st = a.in[I_SCONV] + (size_t)b * 30 * DC + c2;
#pragma unroll
                    for (int i = 0; i < 30; ++i) in[i] = *(const f32x2m*)(st + i * DC);
#pragma unroll
                    for (int i = 30; i < 38; ++i) { const unsigned w = tp[i * 256]; in[i] = MIX_UNPK(w); }
                } }
#pragma unroll
            for (int tt = 0; tt < 8; ++tt) { f32x2m sacc = bdw;
#pragma unroll
                for (int k = 0; k < CW; ++k) sacc = wdw[k] * in[tt + k] + sacc;
                *(LAS f32x2m*)(vbuf + (g * 8 + tt) * DC + c2) = sacc; }
            if (prompt) { if (tb + 8 > SEQ - 30) {
#pragma unroll
                    for (int tt = 0; tt < 8; ++tt) if (tb + tt >= SEQ - 30) *(f32x2m*)(a.out + O_NSCP + (size_t)(b * 30 + tb + tt - (SEQ - 30)) * DC + c2) = in[30 + tt]; }
            } else { float* o = a.out + O_NSCS + (size_t)b * 30 * DC + c2;
#pragma unroll
                for (int e = 8; e < 38; ++e) *(f32x2m*)(o + (e - 8) * DC) = in[e]; }
            f32x2m pin[23];
            { const LAS unsigned* tp = (const LAS unsigned*)(poolT + (g * 8) * 512 + c2);
                if (prompt) {
                    if (tb >= 15) {
#pragma unroll
                        for (int i = 0; i < 23; ++i) { const unsigned w = tp[i * 256]; pin[i] = MIX_UNPK(w); }
                    } else {
#pragma unroll
                        for (int i = 0; i < 23; ++i) { const unsigned w = tp[i * 256]; pin[i] = (tb - 15 + i >= 0) ? MIX_UNPK(w) : zero2; }
                    }
                } else {
                    const float* st = a.in[I_SPOOL] + (size_t)b * 15 * DP + c2;
#pragma unroll
                    for (int i = 0; i < 15; ++i) pin[i] = *(const f32x2m*)(st + i * DP);
#pragma unroll
                    for (int i = 15; i < 23; ++i) { const unsigned w = tp[i * 256]; pin[i] = MIX_UNPK(w); }
                } }
#pragma unroll
            for (int tt = 0; tt < 8; ++tt) { const f32x2m cur = pin[15 + tt];
                const f32x2m s2 = cur + pin[14 + tt], s4 = s2 + (pin[13 + tt] + pin[12 + tt]), s8 = s4 + ((pin[11 + tt] + pin[10 + tt]) + (pin[9 + tt] + pin[8 + tt]));
                const f32x2m s16 = s8 + (((pin[7 + tt] + pin[6 + tt]) + (pin[5 + tt] + pin[4 + tt])) + ((pin[3 + tt] + pin[2 + tt]) + (pin[1 + tt] + pin[0 + tt])));
                const f32x2m ssel = gi == 0 ? s2 : (gi == 1 ? s4 : (gi == 2 ? s8 : s16));
                f32x2m o;
                if (!prompt || tb >= 15) o = ssel * inv_win - cur;
                else { const int cnt = tb + tt + 1 < win ? tb + tt + 1 : win; const float fc = (float)cnt; o = (f32x2m){ssel.x / fc, ssel.y / fc} - cur; }
                *(LAS unsigned*)(pbuf + (g * 8 + tt) * DP + c2) = pk2(o.x, o.y); }
            if (prompt) { if (tb + 8 > SEQ - 15) {
#pragma unroll
                    for (int tt = 0; tt < 8; ++tt) if (tb + tt >= SEQ - 15) *(f32x2m*)(a.out + O_NSPP + (size_t)(b * 15 + tb + tt - (SEQ - 15)) * DP + c2) = pin[15 + tt]; }
            } else { float* o = a.out + O_NSPS + (size_t)b * 15 * DP + c2;
#pragma unroll
                for (int e = 8; e < 23; ++e) *(f32x2m*)(o + (e - 8) * DP) = pin[e]; }
        }
        LDS_WAIT(); __syncthreads();
        {   f32x4 x0[2], x1[2]; float sm[2], sq[2];
#pragma unroll
            for (int h = 0; h < 2; ++h) { const LAS float* vr = vbuf + (wave + 8 * h) * DC + lane * 8; x0[h] = *(const LAS f32x4*)vr; x1[h] = *(const LAS f32x4*)(vr + 4);
                sm[h] = ((x0[h].x + x0[h].y) + (x0[h].z + x0[h].w)) + ((x1[h].x + x1[h].y) + (x1[h].z + x1[h].w));
                sq[h] = ((x0[h].x * x0[h].x + x0[h].y * x0[h].y) + (x0[h].z * x0[h].z + x0[h].w * x0[h].w)) + ((x1[h].x * x1[h].x + x1[h].y * x1[h].y) + (x1[h].z * x1[h].z + x1[h].w * x1[h].w)); }
#pragma unroll
            for (int o = 1; o < 64; o <<= 1) {
#pragma unroll
                for (int h = 0; h < 2; ++h) { sm[h] += __shfl_xor(sm[h], o); sq[h] += __shfl_xor(sq[h], o); } }
            const f32x4 g0 = *(const f32x4*)(a.in[I_LNG] + lane * 8), g1 = *(const f32x4*)(a.in[I_LNG] + lane * 8 + 4), b0v = *(const f32x4*)(a.in[I_LNB] + lane * 8), b1v = *(const f32x4*)(a.in[I_LNB] + lane * 8 + 4);
#pragma unroll
            for (int h = 0; h < 2; ++h) if (h >= g_lo && h < g_hi) { const float mean = sm[h] * (1.0f / DC), var = fmaxf(sq[h] * (1.0f / DC) - mean * mean, 0.f), rstd = 1.0f / sqrtf(var + EPS);
                *(v4u*)(A + (size_t)(row0 + wave + 8 * h) * D + DC + lane * 8) = *(const LAS v4u*)(pbuf + (wave + 8 * h) * DP + lane * 8);
                f32x4 y0 = (x0[h] - mean) * rstd * g0 + b0v, y1 = (x1[h] - mean) * rstd * g1 + b1v;
#pragma unroll
                for (int j2 = 0; j2 < 4; ++j2) { y0[j2] = y0[j2] * pg8::sigmoid_f(y0[j2]); y1[j2] = y1[j2] * pg8::sigmoid_f(y1[j2]); }
                v4u o; o.x = pk2(y0.x, y0.y); o.y = pk2(y0.z, y0.w); o.z = pk2(y1.x, y1.y); o.w = pk2(y1.z, y1.w);
                *(v4u*)(A + (size_t)(row0 + wave + 8 * h) * D + lane * 8) = o; } }
        LDS_WAIT(); __syncthreads();
    }
}
#undef MIX_LOAD
#undef MIX_UNIT
#undef MIX_UNPK
#undef MIX_DECODE

constexpr int N_PHASES = 13;
__global__ void __launch_bounds__(512, 2) fwd_megakernel(Args args) {
    extern __shared__ __attribute__((aligned(16))) unsigned char lds_raw[];
    LAS unsigned char* lds = (LAS unsigned char*)lds_raw;
    const int G = gridDim.x, lo = args.ph_lo, hi = args.ph_hi;
    unsigned char* ws = args.ws;
    float* mod = (float*)(ws + WS_MOD);
    bf16* Abuf = (bf16*)(ws + WS_A); bf16* ACT = (bf16*)(ws + WS_ACT); bf16* HB = (bf16*)(ws + WS_HB);
#define IN(k) (lo <= (k) && (k) < hi)
    volatile LAS unsigned* bst = (volatile LAS unsigned*)(lds + BAR_LDS_OFF);
    if (threadIdx.x < 4) bst[threadIdx.x] = 0u;
    __syncthreads();
    XcdBarrier bar; bar.bar = (unsigned*)ws; bar.x = 0; bar.st = nullptr;
    if (!MK_MULTI_LAUNCH) bar = xcd_barrier_post((unsigned*)ws, bst);
    if (hi > N_PHASES) cg::this_grid().sync();
#if MK_MULTI_LAUNCH
#define SEAM(k) do { } while (0)
#else
#define SEAM(k) do { if (IN(k) && IN((k) + 1)) xcd_barrier(bar); if (PROBE_T >= 0 && blockIdx.x == 0 && threadIdx.x == 0) tst[(k) + 1] = __builtin_amdgcn_s_memrealtime(); } while (0)
#endif
    float* part = (float*)(ws + WS_PART);
    const int bid = (int)blockIdx.x;
    volatile LAS unsigned long long* tst = (volatile LAS unsigned long long*)(lds + 131072 + 512);
    if (PROBE_T >= 0 && blockIdx.x == 0 && threadIdx.x == 0) tst[0] = __builtin_amdgcn_s_memrealtime();
#define PH(k) if (IN(k)) for (int rep_ = 0; rep_ <= ((PROBE_DUP >> (k)) & 1); ++rep_)
    PH(0) { p0_prologue(args, lds, G); } SEAM(0);
    PH(1) { mod_phase(args, lds, G); } SEAM(1);
    PH(2) { norm1_phase(args, G); } SEAM(2);
    PH(3) { pg8::Gemm g{Abuf, (const bf16*)(ws + WS_WUP1), M, 2 * FF, D, 0}; pg8::StaticOrder S; S.init(M, 2 * FF, G, bid, D);
        pg8::EpiGate<0> E{ACT, FF, 1}; pg8::gemm_phase<pg8::EpiGate<0>, pg8::StaticOrder, true, true>(lds, g, S, E);
        if (G == 256 && bid >= 216) convert_items(args, lds, 2 * TR_I_UP, 2 * TR_I_UP + TR_I_DN, (bid - 216) * 8 + (int)(threadIdx.x >> 6), 40 * 8); } SEAM(3);
    PH(4) { pg8::Gemm g{ACT, (const bf16*)(ws + WS_WDN1), M, D, FF, 1}; pg8::SplitOrder S; S.init(NP, M, D, G, bid, FF, 4);
        pg8::EpiResidNorm<0> E{args.in[I_XP], args.out, HB, mod, 2, 3, Abuf, nullptr, part, 4, pg8::RowStatX{(unsigned*)(ws + WS_XBUF), (unsigned*)(ws + WS_CNT), lds + XCH_LDS_OFF}};
        pg8::gemm_phase<pg8::EpiResidNorm<0>, pg8::SplitOrder, true, true>(lds, g, S, E); } SEAM(4);
    PH(5) { sample_norm_phase<11, true, false>(args, lds, G, 3, 2); } SEAM(5);
    PH(6) { pg8::Gemm g{Abuf, (const bf16*)(ws + WS_WIN), M, 1536, D, 0}; pg8::StaticOrder S; S.init(M, 1536, G, bid, D);
        pg8::EpiGate<1> E{ACT, D, 0}; pg8::gemm_phase<pg8::EpiGate<1>, pg8::StaticOrder, true, true>(lds, g, S, E);
        if (G == 256 && bid >= 152) { const int iw = (bid - 152) * 8 + (int)(threadIdx.x >> 6);
            convert_items(args, lds, TR_I_UP, 2 * TR_I_UP, iw, 104 * 8); } } SEAM(6);
    PH(7) { mixer_phase(args, lds, G); } SEAM(7);
    PH(8) { pg8::Gemm g{Abuf, (const bf16*)(ws + WS_WOUT), M, D, D, 0}; pg8::SplitOrder S; S.init(NP, M, D, G, bid, D, 4);
        pg8::EpiResidNorm<1> E{nullptr, args.out, HB, mod, 5, 6, Abuf, nullptr, part, 4, pg8::RowStatX{(unsigned*)(ws + WS_XBUF) + 68 * 256 * 4, (unsigned*)(ws + WS_CNT) + 68 * 64, lds + XCH_LDS_OFF}};
        pg8::gemm_phase<pg8::EpiResidNorm<1>, pg8::SplitOrder, true, true>(lds, g, S, E); } SEAM(8);
    PH(9) { sample_norm_phase<4, false, false>(args, lds, G, 6, 5); } SEAM(9);
    PH(10) { pg8::Gemm g{Abuf, (const bf16*)(ws + WS_WUP2), M, 2 * FF, D, 0}; pg8::StaticOrder S; S.init(M, 2 * FF, G, bid, D);
        pg8::EpiGate<0> E{ACT, FF, 1}; pg8::gemm_phase<pg8::EpiGate<0>, pg8::StaticOrder, true, true>(lds, g, S, E);
        if (G == 256 && bid >= 216) convert_items(args, lds, 2 * TR_I_UP + TR_I_DN, 2 * TR_I_UP + 2 * TR_I_DN, (bid - 216) * 8 + (int)(threadIdx.x >> 6), 40 * 8); } SEAM(10);
    PH(11) { pg8::Gemm g{ACT, (const bf16*)(ws + WS_WDN2), M, D, FF, 1}; pg8::SplitOrder S; S.init(NP, M, D, G, bid, FF, 4);
        pg8::EpiResidNorm<2> E{nullptr, args.out, HB, mod, 8, 0, nullptr, args.in[I_GF], part, 4, pg8::RowStatX{(unsigned*)(ws + WS_XBUF) + 2 * 68 * 256 * 4, (unsigned*)(ws + WS_CNT) + 2 * 68 * 64, lds + XCH_LDS_OFF}};
        pg8::gemm_phase<pg8::EpiResidNorm<2>, pg8::SplitOrder, true, true>(lds, g, S, E); } SEAM(11);
    PH(12) { sample_norm_phase<11, false, true>(args, lds, G, 0, 8); }
#undef PH
    if (PROBE_T >= 0 && blockIdx.x == 0 && threadIdx.x == 0) { const unsigned long long tend = __builtin_amdgcn_s_memrealtime(); tst[N_PHASES] = tend;
        const unsigned long long dl = PROBE_AMP * (tst[PROBE_T + 1] - tst[PROBE_T]); while (__builtin_amdgcn_s_memrealtime() - tend < dl) __builtin_amdgcn_s_sleep(8); }
#undef IN
#undef SEAM
}

extern "C" void kernel_launch(void* const* d_in, const int* in_sizes, int n_in, void* d_out, int out_size, void* d_ws, size_t ws_size, hipStream_t stream) {
    static int grid = 0;
    if (grid == 0) {
        if (n_in != 24 || ws_size < WS_END) { fprintf(stderr, "kernel_launch: unexpected n_in %d / ws %zu\n", n_in, ws_size); grid = -1; return; }
        int dev = 0, cus = 0, per_cu = 0;
        (void)hipGetDevice(&dev); (void)hipDeviceGetAttribute(&cus, hipDeviceAttributeMultiprocessorCount, dev);
        if (hipFuncSetAttribute((const void*)fwd_megakernel, hipFuncAttributeMaxDynamicSharedMemorySize, LDS_BYTES) != hipSuccess) { fprintf(stderr, "kernel_launch: hipFuncSetAttribute failed\n"); grid = -1; return; }
        if (hipOccupancyMaxActiveBlocksPerMultiprocessor(&per_cu, (const void*)fwd_megakernel, 512, LDS_BYTES) != hipSuccess || per_cu < 1) { fprintf(stderr, "kernel_launch: occupancy query says %d blocks/CU\n", per_cu); per_cu = 1; (void)hipGetLastError(); }
        grid = cus > 256 ? 256 : cus;
        if (grid <= 0) grid = 256;
    }
    if (grid < 0) return;
    Args a{};
    for (int i = 0; i < 24; ++i) a.in[i] = (const float*)d_in[i];
    a.out = (float*)d_out; a.ws = (unsigned char*)d_ws;
#if MK_MULTI_LAUNCH
    for (int ph = 0; ph < N_PHASES; ++ph) { a.ph_lo = ph; a.ph_hi = ph + 1; hipLaunchKernelGGL(fwd_megakernel, dim3(grid), dim3(512), LDS_BYTES, stream, a); }
#else
    a.ph_lo = 0; a.ph_hi = N_PHASES;
    if (hipMemsetAsync(d_ws, 0, CTL_ZERO, stream) != hipSuccess) { fprintf(stderr, "kernel_launch: memset of the barrier words failed\n"); return; }
    void* kargs[] = {&a};
    hipError_t e = hipLaunchCooperativeKernel((const void*)fwd_megakernel, dim3(grid), dim3(512), kargs, LDS_BYTES, stream);
    if (e != hipSuccess) fprintf(stderr, "kernel_launch: cooperative launch failed: %s (grid %d)\n", hipGetErrorString(e), grid);
#endif
}
```

```cpp
#include <hip/hip_runtime.h>
#include <hip/hip_cooperative_groups.h>
#include <cstdio>
#include <cstdint>
namespace cg = cooperative_groups;
#define MK_MULTI_LAUNCH 0
namespace pg8 {
#define PG8_LAS __attribute__((address_space(3)))
typedef unsigned short bf16_t;
typedef short bf16x8 __attribute__((ext_vector_type(8)));
typedef float f32x4 __attribute__((ext_vector_type(4)));
typedef unsigned u32x4 __attribute__((ext_vector_type(4)));
constexpr int BM = 256, BK = 64, HALF = 128, HTB = HALF * BK * 2  , STAGE_BYTES = 8 * HTB, NXCD = 8, WGM = 8;

__host__ __device__ __forceinline__ int lds_byte(int r, int c) { const int st = (r >> 4) * 2 + (c >> 5), rr = r & 15, cc = c & 31, ob = rr * 64 + cc * 2; return st * 1024 + (ob ^ (((ob >> 9) & 1) << 5)); }
__host__ __device__ __forceinline__ void stage_rc(int b, int& R, int& C) { const int st = b / 1024, sb = b % 1024, swz = sb ^ (((sb >> 9) & 1) << 5); R = (st >> 1) * 16 + swz / 64; C = (st & 1) * 32 + (swz % 64) / 2; }
__host__ __device__ __forceinline__ int perm32(int rho) { const int n = rho >> 4, i = rho & 15; return 8 * (i >> 2) + 4 * n + (i & 3); }

struct Unit { int pm, pn, kt0, nkt; };
struct Gemm { const bf16_t* A; const bf16_t* Bt; int M, N, K, ta; };

struct StaticOrder {
    int nM, nN, nwg, G, c, nt;
    __host__ __device__ __forceinline__ void init(int M, int N, int G_, int c_, int K) { nM = M / BM; nN = N / BM; nwg = nM * nN; G = G_; c = c_; nt = K / BK; }
    __host__ __device__ __forceinline__ bool next(int i, Unit& u) const {
        const long L = (long)i * G + c; if (L >= nwg) return false;
        int wgid = (int)L; { const int q = nwg / NXCD, r = nwg % NXCD, xcd = wgid % NXCD, off = wgid / NXCD; wgid = (xcd < r ? xcd * (q + 1) : r * (q + 1) + (xcd - r) * q) + off; }
        const int nig = WGM * nN, gid = wgid / nig, fm = gid * WGM, gsz = (nM - fm) < WGM ? (nM - fm) : WGM;
        u.pm = fm + ((wgid % nig) % gsz); u.pn = (wgid % nig) / gsz; u.kt0 = 0; u.nkt = nt; return true;
    }
    __device__ __forceinline__ void a_ready(const Unit&) const {}
    __device__ __forceinline__ void done(const Unit&) const {}
};
struct SplitOrder : StaticOrder {
    int pm0, npieces, ppu, pk, npc;
    __host__ __device__ __forceinline__ void init(int Mfull, int Mtot, int N, int G_, int c_, int K, int pk_) { StaticOrder::init(Mfull, N, G_, c_, K); pm0 = Mfull / BM; pk = pk_; ppu = nt / pk; npieces = ((Mtot - Mfull) / BM) * nN * ppu;
        npc = c < npieces ? (npieces - c + G - 1) / G : 0; }
    __host__ __device__ __forceinline__ bool next(int i, Unit& u) const {
        if (i >= npc) return StaticOrder::next(i - npc, u);
        const int p = i * G + c; const int up = p / ppu, kp = p - up * ppu; u.pm = pm0 + up / nN; u.pn = up % nN; u.kt0 = kp * pk; u.nkt = pk; return true;
    }
};
__device__ __forceinline__ unsigned cvt_pk_bf16(float lo, float hi) { unsigned r; asm volatile("v_cvt_pk_bf16_f32 %0, %1, %2" : "=v"(r) : "v"(lo), "v"(hi)); return r; }
typedef float f32x2 __attribute__((ext_vector_type(2)));
constexpr int NROW_PROMPT = 16384, MODLD = 9216, DM = 1024;
__device__ __forceinline__ int mod_row(int r) { return r < NROW_PROMPT ? (r >> 11) : 8 + ((r - NROW_PROMPT) >> 3); }
__device__ __forceinline__ float sigmoid_f(float g) { return __builtin_amdgcn_rcpf(1.0f + __builtin_amdgcn_exp2f(-1.44269504089f * g)); }

template <int MODE> struct EpiGate {
    static constexpr bool PERM = true, AFTER_DRAIN = false;
    bf16_t* O; int ldc; int tiled;
    __device__ __forceinline__ void operator()(const f32x4 (&acc)[2][2][4][2], const Unit& u, int wr, int wc, int fr, int fq) const {
        const int row0 = u.pm * BM + wr * 64 + fr;
        if (MODE == 0 || u.pn < 4) {
            const int col0 = u.pn * 128 + wc * 32 + 8 * fq;
#pragma unroll
            for (int ai = 0; ai < 2; ++ai)
#pragma unroll
                for (int m = 0; m < 4; ++m) { const int rr = wr * 64 + fr + ai * HALF + m * 16;
                    bf16_t* rowp = tiled ? O + (size_t)(u.pm * (ldc >> 6) + (col0 >> 6)) * (BM * BK) + ai * (HALF * BK) + (lds_byte(rr & 127, col0 & 63) >> 1) : O + (size_t)(row0 + ai * HALF + m * 16) * ldc + col0;
                    f32x2 o[4];
#pragma unroll
                    for (int n = 0; n < 2; ++n)
#pragma unroll
                        for (int j = 0; j < 2; ++j) { const f32x2 a = (f32x2){acc[ai][0][m][n][2 * j], acc[ai][0][m][n][2 * j + 1]}, b = (f32x2){acc[ai][1][m][n][2 * j], acc[ai][1][m][n][2 * j + 1]};
                            const f32x2 x = (MODE == 0) ? a : b, t = x * (-1.44269504089f); f32x2 e; e.x = __builtin_amdgcn_exp2f(t.x); e.y = __builtin_amdgcn_exp2f(t.y);
                            const f32x2 d = e + 1.0f; f32x2 r; r.x = __builtin_amdgcn_rcpf(d.x); r.y = __builtin_amdgcn_rcpf(d.y);
                            o[n * 2 + j] = (MODE == 0) ? (a * r) * b : a * r; }
                    u32x4 w; w.x = cvt_pk_bf16(o[0].x, o[0].y); w.y = cvt_pk_bf16(o[1].x, o[1].y); w.z = cvt_pk_bf16(o[2].x, o[2].y); w.w = cvt_pk_bf16(o[3].x, o[3].y);
                    *(u32x4*)rowp = w; }
        } else {
            const int col0 = 512 + (u.pn - 4) * 256 + wc * 32 + 8 * fq;
#pragma unroll
            for (int ai = 0; ai < 2; ++ai)
#pragma unroll
                for (int m = 0; m < 4; ++m) { bf16_t* rowp = O + (size_t)(row0 + ai * HALF + m * 16) * ldc + col0;
#pragma unroll
                    for (int bj = 0; bj < 2; ++bj) { const f32x4 v0 = acc[ai][bj][m][0], v1 = acc[ai][bj][m][1];
                        u32x4 w; w.x = cvt_pk_bf16(v0[0], v0[1]); w.y = cvt_pk_bf16(v0[2], v0[3]); w.z = cvt_pk_bf16(v1[0], v1[1]); w.w = cvt_pk_bf16(v1[2], v1[3]);
                        *(u32x4*)(rowp + bj * HALF) = w; } }
        }
    }
};
template <bool FROM_X> struct EpiResid {
    static constexpr bool PERM = false, AFTER_DRAIN = false;
    const float* xp; float* h; const float* gate; float* part; int pk;
    __device__ __forceinline__ void operator()(const f32x4 (&acc)[2][2][4][2], const Unit& u, int wr, int wc, int fr, int fq) const {
        const int col0 = u.pn * BM + wc * 32 + 4 * fq;
        if (u.pm * BM >= NROW_PROMPT) {
            float* pbase = part + (size_t)(u.kt0 / pk) * (1024 * DM) + col0;
#pragma unroll
            for (int ai = 0; ai < 2; ++ai)
#pragma unroll
                for (int m = 0; m < 4; ++m) { const int row = u.pm * BM - NROW_PROMPT + ai * HALF + wr * 64 + m * 16 + fr; float* o = pbase + (size_t)row * DM;
#pragma unroll
                    for (int bj = 0; bj < 2; ++bj)
#pragma unroll
                        for (int n = 0; n < 2; ++n) *(f32x4*)(o + bj * HALF + n * 16) = acc[ai][bj][m][n]; }
            return;
        }
#pragma unroll
        for (int ai = 0; ai < 2; ++ai)
#pragma unroll
            for (int m = 0; m < 4; ++m) { const int row = u.pm * BM + ai * HALF + wr * 64 + m * 16 + fr;
                const float* gt = gate + (size_t)(row >> 11) * MODLD + col0;
                const float* base = (FROM_X ? xp + (size_t)row * DM : h + (size_t)row * DM) + col0;
                float* o = h + (size_t)row * DM + col0;
#pragma unroll
                for (int bj = 0; bj < 2; ++bj)
#pragma unroll
                    for (int n = 0; n < 2; ++n) { const int off = bj * HALF + n * 16; const f32x4 b = *(const f32x4*)(base + off), g = *(const f32x4*)(gt + off);
                        *(f32x4*)(o + off) = b + g * acc[ai][bj][m][n]; }
                asm volatile("" ::: "memory"); }
    }
};

struct RowStatX { unsigned* xbuf; unsigned* cnt; PG8_LAS unsigned char* lds; };
template <int MODE> struct EpiResidNorm {
    static constexpr bool PERM = true, AFTER_DRAIN = true;
    const float* xp; float* h; bf16_t* hb; const float* mod; int slot_gate, slot_shift; bf16_t* A; const float* gf; float* part; int pk; RowStatX X;
    static __device__ __forceinline__ u32x4 pack8(const f32x4& a, const f32x4& b) { u32x4 w; w.x = cvt_pk_bf16(a.x, a.y); w.y = cvt_pk_bf16(a.z, a.w); w.z = cvt_pk_bf16(b.x, b.y); w.w = cvt_pk_bf16(b.z, b.w); return w; }
    static __device__ __forceinline__ f32x4 lo4(const u32x4& w) { return (f32x4){__builtin_bit_cast(float, w.x << 16), __builtin_bit_cast(float, w.x & 0xffff0000u), __builtin_bit_cast(float, w.y << 16), __builtin_bit_cast(float, w.y & 0xffff0000u)}; }
    static __device__ __forceinline__ f32x4 hi4(const u32x4& w) { return (f32x4){__builtin_bit_cast(float, w.z << 16), __builtin_bit_cast(float, w.z & 0xffff0000u), __builtin_bit_cast(float, w.w << 16), __builtin_bit_cast(float, w.w & 0xffff0000u)}; }
    __device__ __forceinline__ void store_part(const f32x4 (&acc)[2][2][4][2], const Unit& u, int wr, int wc, int fr, int fq) const {
        const int col0 = u.pn * BM + wc * 32 + 8 * fq;
        bf16_t* pbase = (bf16_t*)part + (size_t)(u.kt0 / pk) * (1024 * DM) + col0;
#pragma unroll
        for (int ai = 0; ai < 2; ++ai)
#pragma unroll
            for (int m = 0; m < 4; ++m) { const int row = u.pm * BM - NROW_PROMPT + ai * HALF + wr * 64 + m * 16 + fr; bf16_t* o = pbase + (size_t)row * DM;
#pragma unroll
                for (int bj = 0; bj < 2; ++bj) *(u32x4*)(o + bj * HALF) = pack8(acc[ai][bj][m][0], acc[ai][bj][m][1]); }
    }
    __device__ __forceinline__ void operator()(const f32x4 (&acc)[2][2][4][2], const Unit& u, int wr, int wc, int fr, int fq) const { store_part(acc, u, wr, wc, fr, fq); }
    __device__ __forceinline__ void fused(const f32x4 (&acc)[2][2][4][2], const Unit& u, int wr, int wc, int fr, int fq, PG8_LAS unsigned char* stage, int wid, int lane) const {
        if (u.pm * BM >= NROW_PROMPT) { store_part(acc, u, wr, wc, fr, fq); return; }
        const int col0 = u.pn * BM + wc * 32 + 8 * fq;
        const int tid = wid * 64 + lane;
        PG8_LAS float* P = (PG8_LAS float*)X.lds; PG8_LAS float* S = (PG8_LAS float*)(X.lds + 4096);
        const float* mrow = mod + (size_t)(u.pm >> 3) * MODLD + col0;
#pragma unroll
        for (int ai = 0; ai < 2; ++ai)
#pragma unroll
            for (int m = 0; m < 4; ++m) { const int rl = ai * HALF + wr * 64 + m * 16 + fr; const size_t roff = (size_t)(u.pm * BM + rl) * DM + col0;
                float s = 0.f;
#pragma unroll
                for (int bj = 0; bj < 2; ++bj) { const int off = bj * HALF;
                    const f32x4 g0 = *(const f32x4*)(mrow + (size_t)slot_gate * DM + off), g1 = *(const f32x4*)(mrow + (size_t)slot_gate * DM + off + 4);
                    f32x4 b0, b1; if (MODE == 0) { b0 = *(const f32x4*)(xp + roff + off); b1 = *(const f32x4*)(xp + roff + off + 4); }
                    else { const u32x4 q = *(const u32x4*)(hb + roff + off); b0 = lo4(q); b1 = hi4(q); }
                    const f32x4 v0 = b0 + g0 * acc[ai][bj][m][0], v1 = b1 + g1 * acc[ai][bj][m][1];
                    const u32x4 w = pack8(v0, v1);
                    if (MODE != 2) *(u32x4*)(hb + roff + off) = w;
                    *(PG8_LAS u32x4*)(stage + (((ai * 4 + m) * 2 + bj) * 512 + tid) * 16) = w;
                    s += ((v0.x * v0.x + v0.y * v0.y) + (v0.z * v0.z + v0.w * v0.w)) + ((v1.x * v1.x + v1.y * v1.y) + (v1.z * v1.z + v1.w * v1.w));
                    asm volatile("" ::: "memory"); }
                s += __shfl_xor(s, 16); s += __shfl_xor(s, 32);
                if (fq == 0) P[rl * 4 + wc] = s;
                asm volatile("" ::: "memory"); }
        asm volatile("s_waitcnt lgkmcnt(0)" ::: "memory"); __builtin_amdgcn_s_barrier(); asm volatile("" ::: "memory");
        if (tid < 256) { const float t = (P[tid * 4 + 0] + P[tid * 4 + 1]) + (P[tid * 4 + 2] + P[tid * 4 + 3]);
            __hip_atomic_store(X.xbuf + ((size_t)(u.pm * BM + tid) * 4 + u.pn), __builtin_bit_cast(unsigned, t), __ATOMIC_RELAXED, __HIP_MEMORY_SCOPE_AGENT);
            asm volatile("s_waitcnt vmcnt(0)" ::: "memory");
            if (lane == 0) __hip_atomic_fetch_add(X.cnt + 64 * u.pm, 1u, __ATOMIC_RELAXED, __HIP_MEMORY_SCOPE_AGENT); }
        if (wid == 0) { unsigned spins = 0;
            while ((unsigned)__builtin_amdgcn_readfirstlane(__hip_atomic_load(X.cnt + 64 * u.pm, __ATOMIC_RELAXED, __HIP_MEMORY_SCOPE_AGENT)) < 16u) { __builtin_amdgcn_s_sleep(2); if (++spins > (1u << 17)) break; }
            __builtin_amdgcn_fence(__ATOMIC_ACQUIRE, "agent"); }
        asm volatile("s_waitcnt vmcnt(0) lgkmcnt(0)" ::: "memory"); __builtin_amdgcn_s_barrier(); asm volatile("" ::: "memory");
        if (tid < 256) { const unsigned* sl = X.xbuf + (size_t)(u.pm * BM + tid) * 4; float q = 0.f;
#pragma unroll
            for (int t = 0; t < 4; ++t) q += __builtin_bit_cast(float, __hip_atomic_load(sl + t, __ATOMIC_RELAXED, __HIP_MEMORY_SCOPE_AGENT));
            S[tid] = 1.0f / sqrtf(q * (1.0f / DM) + 1e-6f); }
        asm volatile("s_waitcnt vmcnt(0) lgkmcnt(0)" ::: "memory"); __builtin_amdgcn_s_barrier(); asm volatile("" ::: "memory");
#pragma unroll
        for (int ai = 0; ai < 2; ++ai)
#pragma unroll
            for (int m = 0; m < 4; ++m) { const int rl = ai * HALF + wr * 64 + m * 16 + fr; const float r = S[rl]; const size_t roff = (size_t)(u.pm * BM + rl) * DM + col0;
#pragma unroll
                for (int bj = 0; bj < 2; ++bj) { const int off = bj * HALF;
                    const u32x4 w = *(const PG8_LAS u32x4*)(stage + (((ai * 4 + m) * 2 + bj) * 512 + tid) * 16); const f32x4 h0 = lo4(w), h1 = hi4(w);
                    if (MODE == 2) { float* o = h + roff + off; *(f32x4*)o = h0 * r * *(const f32x4*)(gf + col0 + off); *(f32x4*)(o + 4) = h1 * r * *(const f32x4*)(gf + col0 + off + 4); }
                    else { const float* cs = mrow + (size_t)(slot_shift + 1) * DM + off; const float* sh = mrow + (size_t)slot_shift * DM + off;
                        const f32x4 y0 = h0 * r * *(const f32x4*)cs + *(const f32x4*)sh, y1 = h1 * r * *(const f32x4*)(cs + 4) + *(const f32x4*)(sh + 4);
                        *(u32x4*)(A + roff + off) = pack8(y0, y1); } }
                asm volatile("" ::: "memory"); }
    }
};
template <class Epi, class Sched, bool ALIGN_EPI = false, bool SP2 = false>
__device__ __forceinline__ void gemm_phase(PG8_LAS unsigned char* lds, const Gemm g, const Sched& S, const Epi& E) {
    const int tid = threadIdx.x, wid = __builtin_amdgcn_readfirstlane(tid >> 6), lane = tid & 63, wr = wid >> 2, wc = wid & 3, fr = lane & 15, fq = lane >> 4;
    const int K = g.K;
    unsigned voffA[2], voffB[2];
#pragma unroll
    for (int i = 0; i < 2; ++i) { int R, C; stage_rc(tid * 16 + i * 8192, R, C); const int Rb = Epi::PERM ? ((R & ~31) + perm32(R & 31)) : R;
        voffA[i] = g.ta ? (unsigned)(tid * 16 + i * 8192)   : (unsigned)(R * K + C) * 2u; voffB[i] = (unsigned)(Rb * K + C) * 2u; }
    const size_t kstep = (size_t)(BK * 2);
    const size_t hstep = (size_t)HALF * K * 2;
    const size_t tstep = 2 * hstep;
    const size_t kstepA = g.ta ? (size_t)(BM * BK * 2) : kstep, hstepA = g.ta ? (size_t)(HALF * BK * 2) : hstep, tstepA = g.ta ? (size_t)BM * K * 2 : tstep;
    const unsigned ldsw = (unsigned)wid * 1024u;
    const int aoff = lds_byte(wr * 64 + fr, fq * 8), boff = lds_byte(wc * 32 + fr, fq * 8);
#define PG8_SA(b, h) (((b) * 2 + (h)) * HTB)
#define PG8_SB(b, h) ((4 + (b) * 2 + (h)) * HTB)
#define PG8_STAGE(bufoff, gbase, voff) do { _Pragma("unroll") for (int _i = 0; _i < 2; ++_i) \
        __builtin_amdgcn_global_load_lds((const unsigned*)((const char*)(gbase) + (voff)[_i]), (PG8_LAS unsigned*)(lds + (bufoff) + ldsw + _i * 8192), 16, 0, 0); } while (0)
#define PG8_LDA(dst, b, h) do { _Pragma("unroll") for (int m = 0; m < 4; ++m) _Pragma("unroll") for (int k = 0; k < 2; ++k) dst[m][k] = *(const PG8_LAS bf16x8*)(lds + PG8_SA(b, h) + aoff + m * 2048 + k * 1024); } while (0)
#define PG8_LDB(dst, b, h) do { _Pragma("unroll") for (int n = 0; n < 2; ++n) _Pragma("unroll") for (int k = 0; k < 2; ++k) dst[n][k] = *(const PG8_LAS bf16x8*)(lds + PG8_SB(b, h) + boff + n * 2048 + k * 1024); } while (0)
#define PG8_MMA(ai, bj, At, Bt) do { __builtin_amdgcn_s_setprio(1); _Pragma("unroll") for (int m = 0; m < 4; ++m) _Pragma("unroll") for (int n = 0; n < 2; ++n) _Pragma("unroll") for (int k = 0; k < 2; ++k) \
        acc[ai][bj][m][n] = __builtin_amdgcn_mfma_f32_16x16x32_bf16(Bt[n][k], At[m][k], acc[ai][bj][m][n], 0, 0, 0); __builtin_amdgcn_s_setprio(0); } while (0)
#define PG8_WAIT_V(n) asm volatile("s_waitcnt vmcnt(" #n ")" ::: "memory")
#define PG8_WAIT_L(n) asm volatile("s_waitcnt lgkmcnt(" #n ")" ::: "memory")
#define PG8_BAR __builtin_amdgcn_s_barrier()
#define PG8_SCHED __builtin_amdgcn_sched_barrier(0)
    Unit cur, nxt; int ui = 0;
    if (!S.next(0, cur)) return;
    f32x4 acc[2][2][4][2];
#pragma unroll
    for (int a = 0; a < 2; ++a)
#pragma unroll
        for (int b = 0; b < 2; ++b)
#pragma unroll
            for (int m = 0; m < 4; ++m)
#pragma unroll
                for (int n = 0; n < 2; ++n) acc[a][b][m][n] = (f32x4){0.f, 0.f, 0.f, 0.f};
    bf16x8 At[4][2], B0[2][2], B1[2][2];
    const char* cA = (const char*)g.A + (size_t)cur.pm * tstepA + (size_t)cur.kt0 * kstepA; const char* cB = (const char*)g.Bt + (size_t)cur.pn * tstep + (size_t)cur.kt0 * kstep;
    S.a_ready(cur);
    if constexpr (SP2) {
        PG8_STAGE(PG8_SB(0, 0), cB, voffB); PG8_STAGE(PG8_SB(0, 1), cB + hstep, voffB); PG8_STAGE(PG8_SA(0, 0), cA, voffA); PG8_STAGE(PG8_SA(0, 1), cA + hstepA, voffA);
        if (wr == 1) PG8_BAR;
        PG8_WAIT_V(2); PG8_BAR;
        PG8_STAGE(PG8_SB(1, 0), cB + kstep, voffB); PG8_STAGE(PG8_SA(1, 0), cA + kstepA, voffA); PG8_STAGE(PG8_SB(1, 1), cB + hstep + kstep, voffB);
        PG8_WAIT_V(6); PG8_BAR;
    } else {
        PG8_STAGE(PG8_SB(0, 0), cB, voffB); PG8_STAGE(PG8_SA(0, 0), cA, voffA); PG8_STAGE(PG8_SB(0, 1), cB + hstep, voffB); PG8_STAGE(PG8_SA(0, 1), cA + hstepA, voffA);
        if (wr == 1) PG8_BAR;
        PG8_WAIT_V(4); PG8_BAR;
        PG8_STAGE(PG8_SB(1, 0), cB + kstep, voffB); PG8_STAGE(PG8_SA(1, 0), cA + kstepA, voffA); PG8_STAGE(PG8_SB(1, 1), cB + hstep + kstep, voffB);
        PG8_WAIT_V(6); PG8_BAR;
    }
    for (;;) {
        const bool has_next = S.next(ui + 1, nxt);
        const char* nA = has_next ? (const char*)g.A + (size_t)nxt.pm * tstepA + (size_t)nxt.kt0 * kstepA : cA; const char* nB = has_next ? (const char*)g.Bt + (size_t)nxt.pn * tstep + (size_t)nxt.kt0 * kstep : cB;
        const int nt = cur.nkt;
        for (int t = 0; t < nt; t += 2) {
            const bool last = (t == nt - 2);
            const char* a1 = cA + (size_t)(t + 1) * kstepA;
            const char* a2 = last ? nA : cA + (size_t)(t + 2) * kstepA; const char* b2 = last ? nB : cB + (size_t)(t + 2) * kstep;
            const char* a3 = a2 + kstepA; const char* b3 = b2 + kstep;
            if (last && has_next) S.a_ready(nxt);
            if constexpr (SP2) {
            PG8_LDB(B0, 0, 0); PG8_LDB(B1, 0, 1); PG8_SCHED; PG8_LDA(At, 0, 0); PG8_STAGE(PG8_SA(1, 1), a1 + hstepA, voffA);
            PG8_WAIT_V(8); PG8_WAIT_L(0); PG8_BAR; PG8_MMA(0, 0, At, B0); PG8_MMA(0, 1, At, B1); PG8_BAR; PG8_SCHED;
            PG8_LDA(At, 0, 1); PG8_STAGE(PG8_SB(0, 0), b2, voffB); PG8_STAGE(PG8_SB(0, 1), b2 + hstep, voffB); PG8_STAGE(PG8_SA(0, 0), a2, voffA);
            PG8_WAIT_V(8); PG8_WAIT_L(0); PG8_BAR; PG8_MMA(1, 0, At, B0); PG8_MMA(1, 1, At, B1); PG8_BAR; PG8_SCHED;
            PG8_LDB(B0, 1, 0); PG8_LDB(B1, 1, 1); PG8_SCHED; PG8_LDA(At, 1, 0); PG8_STAGE(PG8_SA(0, 1), a2 + hstepA, voffA);
            PG8_WAIT_V(8); PG8_WAIT_L(0); PG8_BAR; PG8_MMA(0, 0, At, B0); PG8_MMA(0, 1, At, B1); PG8_BAR; PG8_SCHED;
            PG8_LDA(At, 1, 1); PG8_STAGE(PG8_SB(1, 0), b3, voffB); PG8_STAGE(PG8_SB(1, 1), b3 + hstep, voffB); PG8_STAGE(PG8_SA(1, 0), a3, voffA);
            PG8_WAIT_V(8); PG8_WAIT_L(0); PG8_BAR; PG8_MMA(1, 0, At, B0); PG8_MMA(1, 1, At, B1); PG8_BAR; PG8_SCHED;
            } else {
            PG8_LDB(B0, 0, 0); PG8_SCHED; PG8_LDA(At, 0, 0); PG8_STAGE(PG8_SA(1, 1), a1 + hstepA, voffA);
            PG8_WAIT_L(8); PG8_BAR; PG8_WAIT_L(0); PG8_MMA(0, 0, At, B0); PG8_BAR; PG8_SCHED;
            PG8_LDB(B1, 0, 1); PG8_STAGE(PG8_SB(0, 0), b2, voffB);
            PG8_BAR; PG8_WAIT_L(0); PG8_MMA(0, 1, At, B1); PG8_BAR;
            PG8_LDA(At, 0, 1); PG8_STAGE(PG8_SA(0, 0), a2, voffA);
            PG8_BAR; PG8_WAIT_L(0); PG8_MMA(1, 0, At, B0); PG8_BAR; PG8_SCHED;
            PG8_STAGE(PG8_SB(0, 1), b2 + hstep, voffB);
            PG8_WAIT_V(6); PG8_BAR; PG8_MMA(1, 1, At, B1); PG8_BAR;
            PG8_LDB(B0, 1, 0); PG8_SCHED; PG8_LDA(At, 1, 0); PG8_STAGE(PG8_SA(0, 1), a2 + hstepA, voffA);
            PG8_WAIT_L(8); PG8_BAR; PG8_WAIT_L(0); PG8_MMA(0, 0, At, B0); PG8_BAR; PG8_SCHED;
            PG8_LDB(B1, 1, 1); PG8_STAGE(PG8_SB(1, 0), b3, voffB);
            PG8_BAR; PG8_WAIT_L(0); PG8_MMA(0, 1, At, B1); PG8_BAR;
            PG8_LDA(At, 1, 1); PG8_STAGE(PG8_SA(1, 0), a3, voffA);
            PG8_BAR; PG8_WAIT_L(0); PG8_MMA(1, 0, At, B0); PG8_BAR; PG8_SCHED;
            PG8_STAGE(PG8_SB(1, 1), b3 + hstep, voffB);
            PG8_WAIT_V(6); PG8_BAR; PG8_MMA(1, 1, At, B1); PG8_BAR;
            }
        }
        if constexpr (ALIGN_EPI) { if (wr == 0) PG8_BAR; }
        if constexpr (!Epi::AFTER_DRAIN) { E(acc, cur, wr, wc, fr, fq); S.done(cur); } else { if (has_next) { E(acc, cur, wr, wc, fr, fq); S.done(cur); } }
        if (!has_next) break;
#pragma unroll
        for (int a = 0; a < 2; ++a)
#pragma unroll
            for (int b = 0; b < 2; ++b)
#pragma unroll
                for (int m = 0; m < 4; ++m)
#pragma unroll
                    for (int n = 0; n < 2; ++n) acc[a][b][m][n] = (f32x4){0.f, 0.f, 0.f, 0.f};
        cur = nxt; cA = nA; cB = nB; ++ui;
        if constexpr (ALIGN_EPI) { if (wr == 1) PG8_BAR; }
    }
    PG8_WAIT_V(0);
    if constexpr (!ALIGN_EPI) { if (wr == 0) PG8_BAR; }
    PG8_BAR;
    if constexpr (Epi::AFTER_DRAIN) { E.fused(acc, cur, wr, wc, fr, fq, lds, wid, lane); S.done(cur); }
#undef PG8_SA
#undef PG8_SB
#undef PG8_STAGE
#undef PG8_LDA
#undef PG8_LDB
#undef PG8_MMA
#undef PG8_WAIT_V
#undef PG8_WAIT_L
#undef PG8_BAR
#undef PG8_SCHED
}
}

#ifndef PROBE_DUP
#define PROBE_DUP 0
#endif
#ifndef PROBE_T
#define PROBE_T -1
#endif
#define PROBE_AMP 4
#ifndef MK_MULTI_LAUNCH
#define MK_MULTI_LAUNCH 0
#endif
#define LAS __attribute__((address_space(3)))
typedef unsigned short bf16;
typedef float f32x4 __attribute__((ext_vector_type(4)));
typedef unsigned v4u __attribute__((ext_vector_type(4)));
typedef unsigned v2u __attribute__((ext_vector_type(2)));
typedef short bf16x8 __attribute__((ext_vector_type(8)));

constexpr int D = 1024, NP = 16384  , NS = 1024  , M = NP + NS, SEQ = 2048, DSEQ = 8, NBP = 8, NBS = 128, NB = NBP + NBS;
constexpr int FF = 2816, DC = 512, DP = 512, CW = 31, PM = 16, NMOD = 9, MODN = NMOD * D;
constexpr float EPS = 1e-6f;
constexpr size_t O_Y = 0, O_NSCP = (size_t)M * D, O_NSPP = O_NSCP + (size_t)NBP * 30 * DC, O_NSCS = O_NSPP + (size_t)NBP * 15 * DP, O_NSPS = O_NSCS + (size_t)NBS * 30 * DC;
constexpr size_t MiB = 1u << 20;
constexpr size_t WS_CNT = 16384;
constexpr size_t WS_XBUF = 128 * 1024;
constexpr size_t CTL_ZERO = 128 * 1024;
constexpr size_t WS_MOD = 1 * MiB;
constexpr size_t WS_WUP1 = 6 * MiB;
constexpr size_t WS_WDN1 = 17 * MiB;
constexpr size_t WS_WIN = 23 * MiB;
constexpr size_t WS_WOUT = 26 * MiB;
constexpr size_t WS_WUP2 = 28 * MiB;
constexpr size_t WS_WDN2 = 39 * MiB;
constexpr size_t WS_SC = 45 * MiB;
constexpr size_t WS_HB = 46 * MiB;
constexpr size_t WS_A = 80 * MiB;
constexpr size_t WS_ACT = 114 * MiB;
constexpr size_t WS_PART = 208 * MiB;
constexpr size_t WS_END = 252 * MiB;
constexpr int LDS_BYTES = 147456;
constexpr int XCH_LDS_OFF = 131072 + 1024;
constexpr int BAR_LDS_OFF = 131072 + 256;

__device__ __forceinline__ unsigned pk2(float lo, float hi) { unsigned r; asm("v_cvt_pk_bf16_f32 %0, %1, %2" : "=v"(r) : "v"(lo), "v"(hi)); return r; }
__device__ __forceinline__ unsigned f2bf(float f) { return pk2(f, f) & 0xffffu; }
__device__ __forceinline__ float bf2f(bf16 b) { return __builtin_bit_cast(float, (unsigned)b << 16); }
__device__ __forceinline__ float wave_sum(float v) {
#pragma unroll
    for (int o = 1; o < 64; o <<= 1) v += __shfl_xor(v, o);
    return v;
}
#define LDS_WAIT() asm volatile("s_waitcnt lgkmcnt(0)" ::: "memory")
#define XB_TMO      128
#define XB_XCNT(j)  (256  + 64 * (j))
#define XB_XSUB(j)  (1280 + 64 * (j))
#define XB_XGEN(j)  (2304 + 64 * (j))
#define XB_TOP      3328
#define XB_TOPGEN   3392
#define XCD_BAR_WORDS 3456
#define XB_SPIN_CAP (1u << 18)

__device__ __forceinline__ unsigned xb_ld(unsigned* p)              { return __hip_atomic_load(p, __ATOMIC_RELAXED, __HIP_MEMORY_SCOPE_AGENT); }
__device__ __forceinline__ unsigned xb_add(unsigned* p, unsigned v) { return __hip_atomic_fetch_add(p, v, __ATOMIC_RELAXED, __HIP_MEMORY_SCOPE_AGENT); }
__device__ __forceinline__ unsigned xb_xcc_id() { return (unsigned)__builtin_amdgcn_s_getreg((3 << 11) | 20) & 0xFu; }
#define XB_SPIN(cond, bar) do { unsigned _sp = 0; while (cond) { __builtin_amdgcn_s_sleep(1); \
    if ((++_sp & 255u) == 0u) { if (xb_ld(&(bar)[XB_TMO])) break; if (_sp > XB_SPIN_CAP) { atomicAdd(&(bar)[XB_TMO], 1u); break; } } } } while (0)

struct XcdBarrier {
    unsigned* bar; unsigned x;
    volatile LAS unsigned* st;
};

__device__ __forceinline__ XcdBarrier xcd_barrier_post(unsigned* bar, volatile LAS unsigned* st) {
    XcdBarrier b; b.bar = bar; b.x = xb_xcc_id(); b.st = st;
    if (threadIdx.x == 0) (void)xb_add(&bar[XB_XCNT(b.x)], 1u);
    return b;
}
__device__ __forceinline__ void xcd_barrier_complete(unsigned* bar, unsigned x, unsigned& nloc, unsigned& nx) {
    const unsigned G = gridDim.x * gridDim.y * gridDim.z;
    unsigned sum, cnt, mine, sp = 0u;
    for (;;) {
        sum = 0u; cnt = 0u; mine = 0u;
#pragma unroll
        for (unsigned j = 0; j < 16; ++j) { const unsigned c = xb_ld(&bar[XB_XCNT(j)]); sum += c; cnt += (c > 0u) ? 1u : 0u; mine = (j == x) ? c : mine; }
        if (sum == G) break;
        __builtin_amdgcn_s_sleep(1);
        if ((++sp & 255u) == 0u) { if (xb_ld(&bar[XB_TMO])) break; if (sp > XB_SPIN_CAP) { atomicAdd(&bar[XB_TMO], 1u); break; } }
    }
    nloc = mine > 0u ? mine : 1u; nx = cnt > 0u ? cnt : 1u;
}

__device__ __forceinline__ void xcd_barrier(const XcdBarrier& b) {
    asm volatile("s_waitcnt vmcnt(0)" ::: "memory");
    __syncthreads();
    if (threadIdx.x == 0) {
        unsigned* bar = b.bar;
        __builtin_amdgcn_s_waitcnt(0);
        unsigned nloc = b.st[0], nx = b.st[1];
        if (nloc == 0u) { xcd_barrier_complete(bar, b.x, nloc, nx); b.st[0] = nloc; b.st[1] = nx; }
        const unsigned old = xb_add(&bar[XB_XSUB(b.x)], 1u);
        const unsigned gen = old / nloc;
        if (old + 1u == (gen + 1u) * nloc) {
            __builtin_amdgcn_fence(__ATOMIC_RELEASE, "agent");
            asm volatile("s_waitcnt vmcnt(0)" ::: "memory");
            const unsigned og = xb_add(&bar[XB_TOP], 1u);
            const unsigned tg = og / nx;
            if (og + 1u == (tg + 1u) * nx) xb_add(&bar[XB_TOPGEN], 1u);
            else XB_SPIN(xb_ld(&bar[XB_TOPGEN]) == tg, bar);
            __builtin_amdgcn_fence(__ATOMIC_ACQUIRE, "agent");
            xb_add(&bar[XB_XGEN(b.x)], 1u);
            asm volatile("s_waitcnt vmcnt(0)" ::: "memory");
        } else {
            XB_SPIN(xb_ld(&bar[XB_XGEN(b.x)]) == gen, bar);
            __builtin_amdgcn_fence(__ATOMIC_ACQUIRE, "agent");
            asm volatile("s_waitcnt vmcnt(0)" ::: "memory");
        }
    }
    __syncthreads();
}

struct Args { const float* in[24]; float* out; unsigned char* ws; int ph_lo, ph_hi; };
enum { I_XP = 0, I_XS, I_SCONV, I_SPOOL, I_CP, I_CS, I_WADA, I_BADA, I_G1, I_WUP1, I_WDN1, I_GM, I_WIN, I_WDW, I_BDW, I_LNG, I_LNB, I_WPOOL, I_PSCALE, I_WOUT, I_G2, I_WUP2, I_WDN2, I_GF };

struct TrItem { const float* src; bf16* dst; int ldw, ldt; };
__device__ __forceinline__ void tr_load(const TrItem& t, int lane, f32x4 (&v)[8]) {
    const float* p = t.src + (size_t)(lane >> 3) * t.ldw + (lane & 7) * 4;
#pragma unroll
    for (int i = 0; i < 8; ++i) v[i] = __builtin_nontemporal_load((const f32x4*)(p + (size_t)(8 * i) * t.ldw));
}
__device__ __forceinline__ void tr_to_lds(const f32x4 (&v)[8], LAS float* scr, int lane) {
#pragma unroll
    for (int i = 0; i < 8; ++i) { LAS float* d = scr + (8 * i + (lane >> 3)) * 33 + (lane & 7) * 4; d[0] = v[i].x; d[1] = v[i].y; d[2] = v[i].z; d[3] = v[i].w; }
    LDS_WAIT(); asm volatile("" ::: "memory");
}
__device__ __forceinline__ void tr_store(const TrItem& t, LAS float* scr, int lane) {
    const int c = lane & 7;
#pragma unroll
    for (int j = 0; j < 4; ++j) { const int n = (lane >> 3) + 8 * j; const LAS float* s = scr + (8 * c) * 33 + n;
        v4u o; o.x = pk2(s[0 * 33], s[1 * 33]); o.y = pk2(s[2 * 33], s[3 * 33]); o.z = pk2(s[4 * 33], s[5 * 33]); o.w = pk2(s[6 * 33], s[7 * 33]);
        *(v4u*)(t.dst + (size_t)n * t.ldt + 8 * c) = o; }
    LDS_WAIT(); asm volatile("" ::: "memory");
}
__device__ __forceinline__ int pair_row(int n, int half) { const int sec = n >= half ? 1 : 0, j = n - sec * half; return (j >> 7) * 256 + sec * 128 + (j & 127); }
constexpr int TR_I_UP = (D / 64) * (2 * FF / 32), TR_I_DN = (FF / 64) * (D / 32), TR_I_IN = (D / 64) * (1536 / 32), TR_I_OUT = (512 / 64) * (D / 32), TR_NITEMS = 2 * TR_I_UP + 2 * TR_I_DN + TR_I_IN + TR_I_OUT;
__device__ __forceinline__ TrItem tr_decode(const Args& a, int it) {
    unsigned char* ws = a.ws; int r = it; TrItem t;
    if (r < 2 * TR_I_UP) { const int l = r >= TR_I_UP; r -= l * TR_I_UP; const int nblk = 2 * FF / 32, kb = r / nblk, nb = r % nblk;
        t.ldw = 2 * FF; t.ldt = D; t.src = a.in[l ? I_WUP2 : I_WUP1] + (size_t)(kb * 64) * t.ldw + nb * 32; t.dst = (bf16*)(ws + (l ? WS_WUP2 : WS_WUP1)) + (size_t)pair_row(nb * 32, FF) * D + kb * 64; return t; }
    r -= 2 * TR_I_UP;
    if (r < 2 * TR_I_DN) { const int l = r >= TR_I_DN; r -= l * TR_I_DN; const int nblk = D / 32, kb = r / nblk, nb = r % nblk;
        t.ldw = D; t.ldt = FF; t.src = a.in[l ? I_WDN2 : I_WDN1] + (size_t)(kb * 64) * t.ldw + nb * 32; t.dst = (bf16*)(ws + (l ? WS_WDN2 : WS_WDN1)) + (size_t)(nb * 32) * FF + kb * 64; return t; }
    r -= 2 * TR_I_DN;
    if (r < TR_I_IN) { const int nblk = 1536 / 32, kb = r / nblk, nb = r % nblk, n0 = nb * 32;
        t.ldw = 1536; t.ldt = D; t.src = a.in[I_WIN] + (size_t)(kb * 64) * t.ldw + n0; t.dst = (bf16*)(ws + WS_WIN) + (size_t)(n0 < 1024 ? pair_row(n0, 512) : n0) * D + kb * 64; return t; }
    r -= TR_I_IN;
    { const int nblk = D / 32, kb = r / nblk, nb = r % nblk;
        t.ldw = D; t.ldt = D; t.src = a.in[I_WOUT] + (size_t)(kb * 64) * t.ldw + nb * 32; t.dst = (bf16*)(ws + WS_WOUT) + (size_t)(nb * 32) * D + kb * 64; return t; }
}

__device__ __forceinline__ void convert_items(const Args& a, LAS unsigned char* lds, int lo, int hi, int iw, int NIW) {
    const int lane = threadIdx.x & 63, wave = __builtin_amdgcn_readfirstlane(threadIdx.x >> 6);
    LAS float* scr = (LAS float*)(lds + wave * 16384);
    f32x4 v[8]; int it = lo + iw;
    if (it < hi) tr_load(tr_decode(a, it), lane, v);
    for (; it < hi; it += NIW) {
        tr_to_lds(v, scr, lane);
        if (it + NIW < hi) tr_load(tr_decode(a, it + NIW), lane, v);
        tr_store(tr_decode(a, it), scr, lane);
    }
}
__device__ __forceinline__ void p0_prologue(const Args& a, LAS unsigned char* lds, int G) {
    const int tid = threadIdx.x, lane = tid & 63, wave = __builtin_amdgcn_readfirstlane(tid >> 6);
    unsigned char* ws = a.ws;
    LAS float* scr = (LAS float*)(lds + wave * 16384);
    const int gw = blockIdx.x * 8 + wave, NGW = G * 8;
    if (G == 256) { convert_items(a, lds, 0, TR_I_UP, gw, NGW); convert_items(a, lds, 2 * TR_I_UP + 2 * TR_I_DN, TR_NITEMS, gw, NGW); }
    else convert_items(a, lds, 0, TR_NITEMS, gw, NGW);
    const int gt = blockIdx.x * 512 + tid, NGT = G * 512;
    for (int i = gt; i < 144 * D / 4; i += NGT) { const int row = i / (D / 4), c4 = i % (D / 4);
        f32x4 v = (f32x4){0.f, 0.f, 0.f, 0.f};
        if (row < NBP) v = *(const f32x4*)(a.in[I_CP] + (size_t)row * D + c4 * 4); else if (row < NB) v = *(const f32x4*)(a.in[I_CS] + (size_t)(row - NBP) * D + c4 * 4);
        v2u o; o.x = pk2(v[0] * pg8::sigmoid_f(v[0]), v[1] * pg8::sigmoid_f(v[1])); o.y = pk2(v[2] * pg8::sigmoid_f(v[2]), v[3] * pg8::sigmoid_f(v[3]));
        *(v2u*)((bf16*)(ws + WS_SC) + (size_t)row * D + c4 * 4) = o; }
    __syncthreads();
    {   LAS float* wpl = (LAS float*)lds;
        LAS float* wol = (LAS float*)(lds + 128 * 129 * 4);
        for (int item = blockIdx.x; item < 4 * 64; item += G) { const int g = item >> 6, n0 = (item & 63) * 16;
            const float* wp = a.in[I_WPOOL] + (size_t)g * 128 * 128;
#pragma unroll
            for (int k = 0; k < 8; ++k) { const int q = tid + 512 * k, c = q >> 5, d4 = (q & 31) * 4; const f32x4 v = *(const f32x4*)(wp + c * 128 + d4);
                LAS float* dd = wpl + c * 129 + d4; dd[0] = v.x; dd[1] = v.y; dd[2] = v.z; dd[3] = v.w; }
            { const int d = tid >> 2, n4 = (tid & 3) * 4; const f32x4 v = *(const f32x4*)(a.in[I_WOUT] + (size_t)(512 + 128 * g + d) * D + n0 + n4) * a.in[I_PSCALE][128 * g + d];
                *(LAS f32x4*)(wol + d * 16 + n4) = v; }
            LDS_WAIT(); __syncthreads();
            const int n = tid & 15, cb = (tid >> 4) * 4;
            float acc[4] = {0.f, 0.f, 0.f, 0.f};
#pragma unroll 8
            for (int d = 0; d < 128; ++d) { const float w = wol[d * 16 + n];
#pragma unroll
                for (int i2 = 0; i2 < 4; ++i2) acc[i2] = __builtin_fmaf(wpl[(cb + i2) * 129 + d], w, acc[i2]); }
            v2u o; o.x = pk2(acc[0], acc[1]); o.y = pk2(acc[2], acc[3]);
            *(v2u*)((bf16*)(ws + WS_WOUT) + (size_t)(n0 + n) * D + 512 + 128 * g + cb) = o;
            LDS_WAIT(); __syncthreads();
        } }
}

__device__ __forceinline__ unsigned silu_pk(float x, float y) { return pk2(x * pg8::sigmoid_f(x), y * pg8::sigmoid_f(y)); }
__device__ __forceinline__ void mod_phase(const Args& a, LAS unsigned char* lds, int G) {
    const int tid = threadIdx.x, lane = tid & 63, wave = __builtin_amdgcn_readfirstlane(tid >> 6), fr = lane & 15, fq = lane >> 4;
    float* mod = (float*)(a.ws + WS_MOD); const bf16* SC = (const bf16*)(a.ws + WS_SC);
    const float* W = a.in[I_WADA];
    for (int it = blockIdx.x; it < MODN / 48; it += G) { const int ng = (G % 8 == 0 && G >= 192) ? (it % 8) * 24 + it / 8 : it;
        f32x4 acc[3][9];
#pragma unroll
        for (int t = 0; t < 3; ++t)
#pragma unroll
            for (int i = 0; i < 9; ++i) acc[t][i] = (f32x4){0.f, 0.f, 0.f, 0.f};
#pragma unroll 1
        for (int kp = 0; kp < 2; ++kp) {
            float x[2][3][8]; bf16x8 sf[9];
#pragma unroll
            for (int h = 0; h < 2; ++h) { const int k0 = wave * 128 + (2 * kp + h) * 32 + fq * 8;
#pragma unroll
                for (int t = 0; t < 3; ++t) { const float* wp = W + (size_t)k0 * MODN + ng * 48 + t * 16 + fr;
#pragma unroll
                    for (int j2 = 0; j2 < 8; ++j2) x[h][t][j2] = __builtin_nontemporal_load(wp + (size_t)j2 * MODN); } }
#pragma unroll
            for (int h = 0; h < 2; ++h) { const int k0 = wave * 128 + (2 * kp + h) * 32 + fq * 8;
#pragma unroll
                for (int i = 0; i < 9; ++i) sf[i] = *(const bf16x8*)(SC + (size_t)(16 * i + fr) * D + k0);
                asm volatile("" ::: "memory"); __builtin_amdgcn_sched_barrier(0);
                bf16x8 wf[3];
#pragma unroll
                for (int t = 0; t < 3; ++t) { v4u o; o.x = pk2(x[h][t][0], x[h][t][1]); o.y = pk2(x[h][t][2], x[h][t][3]); o.z = pk2(x[h][t][4], x[h][t][5]); o.w = pk2(x[h][t][6], x[h][t][7]); wf[t] = __builtin_bit_cast(bf16x8, o); }
#pragma unroll
                for (int i = 0; i < 9; ++i)
#pragma unroll
                    for (int t = 0; t < 3; ++t) acc[t][i] = __builtin_amdgcn_mfma_f32_16x16x32_bf16(wf[t], sf[i], acc[t][i], 0, 0, 0);
                asm volatile("" ::: "memory"); __builtin_amdgcn_sched_barrier(0); }
        }
#pragma unroll
        for (int step = 4; step >= 1; step >>= 1) {
            if (wave >= step && wave < 2 * step) { LAS f32x4* sl = (LAS f32x4*)(lds + (wave - step) * 27648) + lane;
#pragma unroll
                for (int t = 0; t < 3; ++t)
#pragma unroll
                    for (int i = 0; i < 9; ++i) sl[(t * 9 + i) * 64] = acc[t][i]; }
            LDS_WAIT(); __syncthreads();
            if (wave < step) { const LAS f32x4* sl = (const LAS f32x4*)(lds + wave * 27648) + lane;
#pragma unroll
                for (int t = 0; t < 3; ++t)
#pragma unroll
                    for (int i = 0; i < 9; ++i) acc[t][i] += sl[(t * 9 + i) * 64]; }
            LDS_WAIT(); __syncthreads();
        }
        if (wave == 0) {
#pragma unroll
            for (int t = 0; t < 3; ++t) { const int n = ng * 48 + t * 16 + 4 * fq, slot = n >> 10, col = n & 1023, kind = slot % 3;
                const f32x4 bias = *(const f32x4*)(a.in[I_BADA] + n);
                f32x4 gv = (f32x4){1.f, 1.f, 1.f, 1.f};
                if (kind == 1) gv = *(const f32x4*)(a.in[slot == 1 ? I_G1 : (slot == 4 ? I_GM : I_G2)] + col);
                const float gs = (slot == 2 || slot == 8) ? 0.5f : 1.0f;
#pragma unroll
                for (int i = 0; i < 9; ++i) { const int b = 16 * i + fr; f32x4 v = acc[t][i] + bias;
                    if (kind == 1) v = gv * (v + 1.0f); else if (kind == 2) v = v * gs;
                    if (b < NB) *(f32x4*)(mod + (size_t)b * MODN + n) = v; } }
        }
    }
}

__device__ __forceinline__ void norm1_phase(const Args& a, int G) {
    const int tid = threadIdx.x, lane = tid & 63, wave = __builtin_amdgcn_readfirstlane(tid >> 6);
    const float* mod = (const float*)(a.ws + WS_MOD); bf16* A = (bf16*)(a.ws + WS_A);
    const int gw = blockIdx.x * 8 + wave, NGW = G * 8;
    for (int row = gw; row < M; row += NGW) {
        const f32x4* xr = (const f32x4*)(row < NP ? a.in[I_XP] + (size_t)row * D : a.in[I_XS] + (size_t)(row - NP) * D) + 2 * lane;
        f32x4 v[4]; float s = 0.f;
#pragma unroll
        for (int j = 0; j < 4; ++j) v[j] = __builtin_nontemporal_load(xr + (j >> 1) * 128 + (j & 1));
#pragma unroll
        for (int j = 0; j < 4; ++j) s += (v[j].x * v[j].x + v[j].y * v[j].y) + (v[j].z * v[j].z + v[j].w * v[j].w);
        const float r = 1.0f / sqrtf(wave_sum(s) * (1.0f / D) + EPS);
        const float* mrow = mod + (size_t)pg8::mod_row(row) * MODN;
        const f32x4* sh = (const f32x4*)mrow + 2 * lane; const f32x4* cs = (const f32x4*)(mrow + D) + 2 * lane;
        v4u* o16 = (v4u*)(A + (size_t)row * D) + lane;
#pragma unroll
        for (int jp = 0; jp < 2; ++jp) { const f32x4 y0 = v[2 * jp] * r * cs[jp * 128] + sh[jp * 128], y1 = v[2 * jp + 1] * r * cs[jp * 128 + 1] + sh[jp * 128 + 1];
            v4u o; o.x = pk2(y0.x, y0.y); o.y = pk2(y0.z, y0.w); o.z = pk2(y1.x, y1.y); o.w = pk2(y1.z, y1.w); o16[64 * jp] = o; }
    }
}

template <int NPARTS, bool BASE_X, bool FINAL> __device__ __forceinline__ void sample_norm_phase(const Args& a, LAS unsigned char* lds, int G, int slot_shift, int slot_gate) {
    const int tid = threadIdx.x, lane = tid & 63, wave = __builtin_amdgcn_readfirstlane(tid >> 6), rq = wave & 3, half = wave >> 2;
    const float* mod = (const float*)(a.ws + WS_MOD); bf16* A = (bf16*)(a.ws + WS_A); const float* part = (const float*)(a.ws + WS_PART); bf16* HB = (bf16*)(a.ws + WS_HB);
    LAS float* ss = (LAS float*)lds;
    for (int rb = blockIdx.x; rb < NS / 4; rb += G) {
        const int rs = rb * 4 + rq, row = NP + rs;
        f32x4* yrow = (f32x4*)(a.out + (size_t)row * D) + lane + 128 * half;
        v2u* hbrow = (v2u*)(HB + (size_t)row * D) + lane + 128 * half;
        const f32x4* xrow = (const f32x4*)(a.in[I_XS] + (size_t)rs * D) + lane + 128 * half;
        const float* mr = mod + (size_t)(NBP + (rs >> 3)) * MODN;
        const f32x4* gt = (const f32x4*)(mr + (size_t)slot_gate * D) + lane + 128 * half;
        const v2u* pr = (const v2u*)((const bf16*)part + (size_t)rs * D) + lane + 128 * half;
        f32x4 v[2]; float s = 0.f;
#pragma unroll
        for (int j = 0; j < 2; ++j) { f32x4 acc = (f32x4){0.f, 0.f, 0.f, 0.f};
#pragma unroll
            for (int p = 0; p < NPARTS; ++p) { const v2u q = pr[(size_t)p * (1024 * D / 4) + 64 * j]; acc += (f32x4){bf2f((bf16)(q.x & 0xffffu)), bf2f((bf16)(q.x >> 16)), bf2f((bf16)(q.y & 0xffffu)), bf2f((bf16)(q.y >> 16))}; }
            f32x4 bv; if (BASE_X) bv = xrow[64 * j]; else { const v2u q = hbrow[64 * j]; bv = (f32x4){bf2f((bf16)(q.x & 0xffffu)), bf2f((bf16)(q.x >> 16)), bf2f((bf16)(q.y & 0xffffu)), bf2f((bf16)(q.y >> 16))}; }
            v[j] = bv + gt[64 * j] * acc;
            { v2u w; w.x = pk2(v[j].x, v[j].y); w.y = pk2(v[j].z, v[j].w); if (!FINAL) hbrow[64 * j] = w;
              v[j] = (f32x4){bf2f((bf16)(w.x & 0xffffu)), bf2f((bf16)(w.x >> 16)), bf2f((bf16)(w.y & 0xffffu)), bf2f((bf16)(w.y >> 16))}; }
            s += (v[j].x * v[j].x + v[j].y * v[j].y) + (v[j].z * v[j].z + v[j].w * v[j].w); }
        s = wave_sum(s);
        if (lane == 0) ss[wave] = s;
        LDS_WAIT(); __syncthreads();
        const float r = 1.0f / sqrtf((ss[rq] + ss[rq + 4]) * (1.0f / D) + EPS);
        if (FINAL) { const f32x4* gf = (const f32x4*)a.in[I_GF] + lane + 128 * half;
#pragma unroll
            for (int j = 0; j < 2; ++j) yrow[64 * j] = v[j] * r * gf[64 * j];
        } else { const f32x4* sh = (const f32x4*)(mr + (size_t)slot_shift * D) + lane + 128 * half; const f32x4* cs = (const f32x4*)(mr + (size_t)(slot_shift + 1) * D) + lane + 128 * half;
            v2u* o8 = (v2u*)(A + (size_t)row * D) + lane + 128 * half;
#pragma unroll
            for (int j = 0; j < 2; ++j) { const f32x4 y = v[j] * r * cs[64 * j] + sh[64 * j]; v2u o; o.x = pk2(y.x, y.y); o.y = pk2(y.z, y.w); o8[64 * j] = o; } }
        LDS_WAIT(); __syncthreads();
    }
}

constexpr int MIX_CONV_ROWS = 46, MIX_POOL_ROWS = 31, MIX_POOL_OFF = MIX_CONV_ROWS * 1024, MIX_V_OFF = MIX_POOL_OFF + MIX_POOL_ROWS * 1024, MIX_NU = NS / 16 + NP / 16;
#define MIX_DECODE(u_, prompt_, b_, t0_, row0_) const bool prompt_ = (u_) >= NS / 16; const int b_ = prompt_ ? ((u_) - NS / 16) / (SEQ / 16) : (u_) * 2, t0_ = prompt_ ? (((u_) - NS / 16) % (SEQ / 16)) * 16 : 0, row0_ = prompt_ ? b_ * SEQ + t0_ : NP + (u_) * 16
#define MIX_LOAD(u_) do { MIX_DECODE(u_, p_, bb_, tt0_, r0_); (void)p_; (void)bb_; (void)tt0_; \
        _Pragma("unroll") for (int k = 0; k < 6; ++k) { const int q = tid + 512 * k; if (q < MIX_CONV_ROWS * 64) pc[k] = *(const v4u*)(U + (long)(r0_ - 30 + (q >> 6)) * D + (q & 63) * 8); } \
        _Pragma("unroll") for (int k = 0; k < 4; ++k) { const int q = tid + 512 * k; if (q < MIX_POOL_ROWS * 64) pp[k] = *(const v4u*)(U + (long)(r0_ - 15 + (q >> 6)) * D + DC + (q & 63) * 8); } } while (0)
__device__ __forceinline__ void mixer_phase(const Args& a, LAS unsigned char* lds, int G) {
    const int tid = threadIdx.x, lane = tid & 63, wave = __builtin_amdgcn_readfirstlane(tid >> 6), c = tid;
    const bf16* U = (const bf16*)(a.ws + WS_ACT); bf16* A = (bf16*)(a.ws + WS_A);
    LAS bf16* convT = (LAS bf16*)lds; LAS bf16* poolT = (LAS bf16*)(lds + MIX_POOL_OFF); LAS float* vbuf = (LAS float*)(lds + MIX_V_OFF);
    typedef float f32x2m __attribute__((ext_vector_type(2)));
#define MIX_UNPK(w_) ((f32x2m){__builtin_bit_cast(float, (w_) << 16), __builtin_bit_cast(float, (w_) & 0xffff0000u)})
    const int grp = wave >> 2, c2 = 2 * (tid & 255);
    f32x2m wdw[CW];
#pragma unroll
    for (int k = 0; k < CW; ++k) wdw[k] = *(const f32x2m*)(a.in[I_WDW] + k * DC + c2);
    const f32x2m bdw = *(const f32x2m*)(a.in[I_BDW] + c2);
    const int gi = c2 >> 7, win = 2 << gi; const float inv_win = 1.0f / (float)win;
    v4u pc[6], pp[4];
    LAS bf16* pbuf = (LAS bf16*)(lds + MIX_V_OFF + 16 * DC * 4);
    const bool split_tail = (G == 256);
    const int bx = (int)blockIdx.x, nit = split_tail ? (bx < 128 ? 5 : 4) : (bx < MIX_NU ? (MIX_NU - bx + G - 1) / G : 0);
#define MIX_UNIT(i_) (split_tail ? ((i_) < 4 ? NS / 16 + ((bx & 7) * 128 + 32 * (i_) + (bx >> 3)) : (bx & 63)) : bx + G * (i_))
    if (nit > 0) MIX_LOAD(MIX_UNIT(0));
    for (int iter = 0; iter < nit; ++iter) { const int uidx = MIX_UNIT(iter);
        const int g_lo = (split_tail && iter == 4 && bx >= 64) ? 1 : 0, g_hi = (split_tail && iter == 4 && bx < 64) ? 1 : 2;
#pragma unroll
        for (int k = 0; k < 6; ++k) { const int q = tid + 512 * k; if (q < MIX_CONV_ROWS * 64) *(LAS v4u*)(convT + (q >> 6) * 512 + (q & 63) * 8) = pc[k]; }
#pragma unroll
        for (int k = 0; k < 4; ++k) { const int q = tid + 512 * k; if (q < MIX_POOL_ROWS * 64) *(LAS v4u*)(poolT + (q >> 6) * 512 + (q & 63) * 8) = pp[k]; }
        LDS_WAIT(); __syncthreads();
        if (iter + 1 < nit) MIX_LOAD(MIX_UNIT(iter + 1));
        MIX_DECODE(uidx, prompt, b0, t0, row0);
        if (grp >= g_lo && grp < g_hi) { const int g = grp;
            const int tb = t0 + g * 8, b = prompt ? b0 : b0 + g;
            const f32x2m zero2 = (f32x2m){0.f, 0.f};
            f32x2m in[38];
            { const LAS unsigned* tp = (const LAS unsigned*)(convT + (g * 8) * 512 + c2);
                if (prompt) {
                    if (tb >= 30) {
#pragma unroll
                        for (int i = 0; i < 38; ++i) { const unsigned w = tp[i * 256]; in[i] = MIX_UNPK(w); }
                    } else {
#pragma unroll
                        for (int i = 0; i < 38; ++i) { const unsigned w = tp[i * 256]; in[i] = (tb - 30 + i >= 0) ? MIX_UNPK(w) : zero2; }
                    }
                } else {
                    const float* st = a.in[I_SCONV] + (size_t)b * 30 * DC + c2;
#pragma unroll
                    for (int i = 0; i < 30; ++i) in[i] = *(const f32x2m*)(st + i * DC);
#pragma unroll
                    for (int i = 30; i < 38; ++i) { const unsigned w = tp[i * 256]; in[i] = MIX_UNPK(w); }
                } }
#pragma unroll
            for (int tt = 0; tt < 8; ++tt) { f32x2m sacc = bdw;
#pragma unroll
                for (int k = 0; k < CW; ++k) sacc = wdw[k] * in[tt + k] + sacc;
                *(LAS f32x2m*)(vbuf + (g * 8 + tt) * DC + c2) = sacc; }
            if (prompt) { if (tb + 8 > SEQ - 30) {
#pragma unroll
                    for (int tt = 0; tt < 8; ++tt) if (tb + tt >= SEQ - 30) *(f32x2m*)(a.out + O_NSCP + (size_t)(b * 30 + tb + tt - (SEQ - 30)) * DC + c2) = in[30 + tt]; }
            } else { float* o = a.out + O_NSCS + (size_t)b * 30 * DC + c2;
#pragma unroll
                for (int e = 8; e < 38; ++e) *(f32x2m*)(o + (e - 8) * DC) = in[e]; }
            f32x2m pin[23];
            { const LAS unsigned* tp = (const LAS unsigned*)(poolT + (g * 8) * 512 + c2);
                if (prompt) {
                    if (tb >= 15) {
#pragma unroll
                        for (int i = 0; i < 23; ++i) { const unsigned w = tp[i * 256]; pin[i] = MIX_UNPK(w); }
                    } else {
#pragma unroll
                        for (int i = 0; i < 23; ++i) { const unsigned w = tp[i * 256]; pin[i] = (tb - 15 + i >= 0) ? MIX_UNPK(w) : zero2; }
                    }
                } else {
                    const float* st = a.in[I_SPOOL] + (size_t)b * 15 * DP + c2;
#pragma unroll
                    for (int i = 0; i < 15; ++i) pin[i] = *(const f32x2m*)(st + i * DP);
#pragma unroll
                    for (int i = 15; i < 23; ++i) { const unsigned w = tp[i * 256]; pin[i] = MIX_UNPK(w); }
                } }
#pragma unroll
            for (int tt = 0; tt < 8; ++tt) { const f32x2m cur = pin[15 + tt];
                const f32x2m s2 = cur + pin[14 + tt], s4 = s2 + (pin[13 + tt] + pin[12 + tt]), s8 = s4 + ((pin[11 + tt] + pin[10 + tt]) + (pin[9 + tt] + pin[8 + tt]));
                const f32x2m s16 = s8 + (((pin[7 + tt] + pin[6 + tt]) + (pin[5 + tt] + pin[4 + tt])) + ((pin[3 + tt] + pin[2 + tt]) + (pin[1 + tt] + pin[0 + tt])));
                const f32x2m ssel = gi == 0 ? s2 : (gi == 1 ? s4 : (gi == 2 ? s8 : s16));
                f32x2m o;
                if (!prompt || tb >= 15) o = ssel * inv_win - cur;
                else { const int cnt = tb + tt + 1 < win ? tb + tt + 1 : win; const float fc = (float)cnt; o = (f32x2m){ssel.x / fc, ssel.y / fc} - cur; }
                *(LAS unsigned*)(pbuf + (g * 8 + tt) * DP + c2) = pk2(o.x, o.y); }
            if (prompt) { if (tb + 8 > SEQ - 15) {
#pragma unroll
                    for (int tt = 0; tt < 8; ++tt) if (tb + tt >= SEQ - 15) *(f32x2m*)(a.out + O_NSPP + (size_t)(b * 15 + tb + tt - (SEQ - 15)) * DP + c2) = pin[15 + tt]; }
            } else { float* o = a.out + O_NSPS + (size_t)b * 15 * DP + c2;
#pragma unroll
                for (int e = 8; e < 23; ++e) *(f32x2m*)(o + (e - 8) * DP) = pin[e]; }
        }
        LDS_WAIT(); __syncthreads();
        {   f32x4 x0[2], x1[2]; float sm[2], sq[2];
#pragma unroll
            for (int h = 0; h < 2; ++h) { const LAS float* vr = vbuf + (wave + 8 * h) * DC + lane * 8; x0[h] = *(const LAS f32x4*)vr; x1[h] = *(const LAS f32x4*)(vr + 4);
                sm[h] = ((x0[h].x + x0[h].y) + (x0[h].z + x0[h].w)) + ((x1[h].x + x1[h].y) + (x1[h].z + x1[h].w));
                sq[h] = ((x0[h].x * x0[h].x + x0[h].y * x0[h].y) + (x0[h].z * x0[h].z + x0[h].w * x0[h].w)) + ((x1[h].x * x1[h].x + x1[h].y * x1[h].y) + (x1[h].z * x1[h].z + x1[h].w * x1[h].w)); }
#pragma unroll
            for (int o = 1; o < 64; o <<= 1) {
#pragma unroll
                for (int h = 0; h < 2; ++h) { sm[h] += __shfl_xor(sm[h], o); sq[h] += __shfl_xor(sq[h], o); } }
            const f32x4 g0 = *(const f32x4*)(a.in[I_LNG] + lane * 8), g1 = *(const f32x4*)(a.in[I_LNG] + lane * 8 + 4), b0v = *(const f32x4*)(a.in[I_LNB] + lane * 8), b1v = *(const f32x4*)(a.in[I_LNB] + lane * 8 + 4);
#pragma unroll
            for (int h = 0; h < 2; ++h) if (h >= g_lo && h < g_hi) { const float mean = sm[h] * (1.0f / DC), var = fmaxf(sq[h] * (1.0f / DC) - mean * mean, 0.f), rstd = 1.0f / sqrtf(var + EPS);
                *(v4u*)(A + (size_t)(row0 + wave + 8 * h) * D + DC + lane * 8) = *(const LAS v4u*)(pbuf + (wave + 8 * h) * DP + lane * 8);
                f32x4 y0 = (x0[h] - mean) * rstd * g0 + b0v, y1 = (x1[h] - mean) * rstd * g1 + b1v;
#pragma unroll
                for (int j2 = 0; j2 < 4; ++j2) { y0[j2] = y0[j2] * pg8::sigmoid_f(y0[j2]); y1[j2] = y1[j2] * pg8::sigmoid_f(y1[j2]); }
                v4u o; o.x = pk2(y0.x, y0.y); o.y = pk2(y0.z, y0.w); o.z = pk2(y1.x, y1.y); o.w = pk2(y1.z, y1.w);
                *(v4u*)(A + (size_t)(row0 + wave + 8 * h) * D + lane * 8) = o; } }
        LDS_WAIT(); __syncthreads();
    }
}
#undef MIX_LOAD
#undef MIX_UNIT
#undef MIX_UNPK
#undef MIX_DECODE

constexpr int N_PHASES = 13;
__global__ void __launch_bounds__(512, 2) fwd_megakernel(Args args) {
    extern __shared__ __attribute__((aligned(16))) unsigned char lds_raw[];
    LAS unsigned char* lds = (LAS unsigned char*)lds_raw;
    const int G = gridDim.x, lo = args.ph_lo, hi = args.ph_hi;
    unsigned char* ws = args.ws;
    float* mod = (float*)(ws + WS_MOD);
    bf16* Abuf = (bf16*)(ws + WS_A); bf16* ACT = (bf16*)(ws + WS_ACT); bf16* HB = (bf16*)(ws + WS_HB);
#define IN(k) (lo <= (k) && (k) < hi)
    volatile LAS unsigned* bst = (volatile LAS unsigned*)(lds + BAR_LDS_OFF);
    if (threadIdx.x < 4) bst[threadIdx.x] = 0u;
    __syncthreads();
    XcdBarrier bar; bar.bar = (unsigned*)ws; bar.x = 0; bar.st = nullptr;
    if (!MK_MULTI_LAUNCH) bar = xcd_barrier_post((unsigned*)ws, bst);
    if (hi > N_PHASES) cg::this_grid().sync();
#if MK_MULTI_LAUNCH
#define SEAM(k) do { } while (0)
#else
#define SEAM(k) do { if (IN(k) && IN((k) + 1)) xcd_barrier(bar); if (PROBE_T >= 0 && blockIdx.x == 0 && threadIdx.x == 0) tst[(k) + 1] = __builtin_amdgcn_s_memrealtime(); } while (0)
#endif
    float* part = (float*)(ws + WS_PART);
    const int bid = (int)blockIdx.x;
    volatile LAS unsigned long long* tst = (volatile LAS unsigned long long*)(lds + 131072 + 512);
    if (PROBE_T >= 0 && blockIdx.x == 0 && threadIdx.x == 0) tst[0] = __builtin_amdgcn_s_memrealtime();
#define PH(k) if (IN(k)) for (int rep_ = 0; rep_ <= ((PROBE_DUP >> (k)) & 1); ++rep_)
    PH(0) { p0_prologue(args, lds, G); } SEAM(0);
    PH(1) { mod_phase(args, lds, G); } SEAM(1);
    PH(2) { norm1_phase(args, G); } SEAM(2);
    PH(3) { pg8::Gemm g{Abuf, (const bf16*)(ws + WS_WUP1), M, 2 * FF, D, 0}; pg8::StaticOrder S; S.init(M, 2 * FF, G, bid, D);
        pg8::EpiGate<0> E{ACT, FF, 1}; pg8::gemm_phase<pg8::EpiGate<0>, pg8::StaticOrder, true, true>(lds, g, S, E);
        if (G == 256 && bid >= 216) convert_items(args, lds, 2 * TR_I_UP, 2 * TR_I_UP + TR_I_DN, (bid - 216) * 8 + (int)(threadIdx.x >> 6), 40 * 8); } SEAM(3);
    PH(4) { pg8::Gemm g{ACT, (const bf16*)(ws + WS_WDN1), M, D, FF, 1}; pg8::SplitOrder S; S.init(NP, M, D, G, bid, FF, 4);
        pg8::EpiResidNorm<0> E{args.in[I_XP], args.out, HB, mod, 2, 3, Abuf, nullptr, part, 4, pg8::RowStatX{(unsigned*)(ws + WS_XBUF), (unsigned*)(ws + WS_CNT), lds + XCH_LDS_OFF}};
        pg8::gemm_phase<pg8::EpiResidNorm<0>, pg8::SplitOrder, true, true>(lds, g, S, E); } SEAM(4);
    PH(5) { sample_norm_phase<11, true, false>(args, lds, G, 3, 2); } SEAM(5);
    PH(6) { pg8::Gemm g{Abuf, (const bf16*)(ws + WS_WIN), M, 1536, D, 0}; pg8::StaticOrder S; S.init(M, 1536, G, bid, D);
        pg8::EpiGate<1> E{ACT, D, 0}; pg8::gemm_phase<pg8::EpiGate<1>, pg8::StaticOrder, true, true>(lds, g, S, E);
        if (G == 256 && bid >= 152) { const int iw = (bid - 152) * 8 + (int)(threadIdx.x >> 6);
            convert_items(args, lds, TR_I_UP, 2 * TR_I_UP, iw, 104 * 8); } } SEAM(6);
    PH(7) { mixer_phase(args, lds, G); } SEAM(7);
    PH(8) { pg8::Gemm g{Abuf, (const bf16*)(ws + WS_WOUT), M, D, D, 0}; pg8::SplitOrder S; S.init(NP, M, D, G, bid, D, 4);
        pg8::EpiResidNorm<1> E{nullptr, args.out, HB, mod, 5, 6, Abuf, nullptr, part, 4, pg8::RowStatX{(unsigned*)(ws + WS_XBUF) + 68 * 256 * 4, (unsigned*)(ws + WS_CNT) + 68 * 64, lds + XCH_LDS_OFF}};
        pg8::gemm_phase<pg8::EpiResidNorm<1>, pg8::SplitOrder, true, true>(lds, g, S, E); } SEAM(8);
    PH(9) { sample_norm_phase<4, false, false>(args, lds, G, 6, 5); } SEAM(9);
    PH(10) { pg8::Gemm g{Abuf, (const bf16*)(ws + WS_WUP2), M, 2 * FF, D, 0}; pg8::StaticOrder S; S.init(M, 2 * FF, G, bid, D);
        pg8::EpiGate<0> E{ACT, FF, 1}; pg8::gemm_phase<pg8::EpiGate<0>, pg8::StaticOrder, true, true>(lds, g, S, E);
        if (G == 256 && bid >= 216) convert_items(args, lds, 2 * TR_I_UP + TR_I_DN, 2 * TR_I_UP + 2 * TR_I_DN, (bid - 216) * 8 + (int)(threadIdx.x >> 6), 40 * 8); } SEAM(10);
    PH(11) { pg8::Gemm g{ACT, (const bf16*)(ws + WS_WDN2), M, D, FF, 1}; pg8::SplitOrder S; S.init(NP, M, D, G, bid, FF, 4);
        pg8::EpiResidNorm<2> E{nullptr, args.out, HB, mod, 8, 0, nullptr, args.in[I_GF], part, 4, pg8::RowStatX{(unsigned*)(ws + WS_XBUF) + 2 * 68 * 256 * 4, (unsigned*)(ws + WS_CNT) + 2 * 68 * 64, lds + XCH_LDS_OFF}};
        pg8::gemm_phase<pg8::EpiResidNorm<2>, pg8::SplitOrder, true, true>(lds, g, S, E); } SEAM(11);
    PH(12) { sample_norm_phase<11, false, true>(args, lds, G, 0, 8); }
#undef PH
    if (PROBE_T >= 0 && blockIdx.x == 0 && threadIdx.x == 0) { const unsigned long long tend = __builtin_amdgcn_s_memrealtime(); tst[N_PHASES] = tend;
        const unsigned long long dl = PROBE_AMP * (tst[PROBE_T + 1] - tst[PROBE_T]); while (__builtin_amdgcn_s_memrealtime() - tend < dl) __builtin_amdgcn_s_sleep(8); }
#undef IN
#undef SEAM
}

extern "C" void kernel_launch(void* const* d_in, const int* in_sizes, int n_in, void* d_out, int out_size, void* d_ws, size_t ws_size, hipStream_t stream) {
    static int grid = 0;
    if (grid == 0) {
        if (n_in != 24 || ws_size < WS_END) { fprintf(stderr, "kernel_launch: unexpected n_in %d / ws %zu\n", n_in, ws_size); grid = -1; return; }
        int dev = 0, cus = 0, per_cu = 0;
        (void)hipGetDevice(&dev); (void)hipDeviceGetAttribute(&cus, hipDeviceAttributeMultiprocessorCount, dev);
        if (hipFuncSetAttribute((const void*)fwd_megakernel, hipFuncAttributeMaxDynamicSharedMemorySize, LDS_BYTES) != hipSuccess) { fprintf(stderr, "kernel_launch: hipFuncSetAttribute failed\n"); grid = -1; return; }
        if (hipOccupancyMaxActiveBlocksPerMultiprocessor(&per_cu, (const void*)fwd_megakernel, 512, LDS_BYTES) != hipSuccess || per_cu < 1) { fprintf(stderr, "kernel_launch: occupancy query says %d blocks/CU\n", per_cu); per_cu = 1; (void)hipGetLastError(); }
        grid = cus > 256 ? 256 : cus;
        if (grid <= 0) grid = 256;
    }
    if (grid < 0) return;
    Args a{};
    for (int i = 0; i < 24; ++i) a.in[i] = (const float*)d_in[i];
    a.out = (float*)d_out; a.ws = (unsigned char*)d_ws;
#if MK_MULTI_LAUNCH
    for (int ph = 0; ph < N_PHASES; ++ph) { a.ph_lo = ph; a.ph_hi = ph + 1; hipLaunchKernelGGL(fwd_megakernel, dim3(grid), dim3(512), LDS_BYTES, stream, a); }
#else
    a.ph_lo = 0; a.ph_hi = N_PHASES;
    if (hipMemsetAsync(d_ws, 0, CTL_ZERO, stream) != hipSuccess) { fprintf(stderr, "kernel_launch: memset of the barrier words failed\n"); return; }
    void* kargs[] = {&a};
    hipError_t e = hipLaunchCooperativeKernel((const void*)fwd_megakernel, dim3(grid), dim3(512), kargs, LDS_BYTES, stream);
    if (e != hipSuccess) fprintf(stderr, "kernel_launch: cooperative launch failed: %s (grid %d)\n", hipGetErrorString(e), grid);
#endif
}
```
